# Optimizing an MI355X kernel written in HIP

```python
import math
import jax, jax.numpy as jnp
from jax import lax
import numpy as np

D_MODEL = 2048
BATCH = 8
SEQ = 2048
DEPTH = 2

GRID_W = 64
CTX_LEN = 256
EPS = 1e-6
NA_HEADS = 8
NA_HEAD_DIM = 128
NA_WIDTH = NA_HEADS * NA_HEAD_DIM
NA_WIN_R = 8
NA_WIN_C = 16
NA_QBLK = 16
NA_KBLK = 32
FOUR_GROUPS = 4
FOUR_GROUP_DIM = 256
FOUR_WIDTH = FOUR_GROUPS * FOUR_GROUP_DIM
SSD_HEADS = 16
SSD_HEAD_DIM = 64
SSD_WIDTH = SSD_HEADS * SSD_HEAD_DIM
SSD_GROUPS = 4
SSD_HPG = SSD_HEADS // SSD_GROUPS
SSD_STATE = 128
SSD_CONV = 7
SSD_CHUNK = 128
SSD_CONV_CH = SSD_WIDTH + 2 * SSD_GROUPS * SSD_STATE
ROPE_BASE = 10000.0
IN_SPLITS = (NA_WIDTH, NA_WIDTH, NA_WIDTH, NA_WIDTH, FOUR_WIDTH, FOUR_WIDTH,
             SSD_CONV_CH, SSD_WIDTH, 2 * SSD_HEADS, D_MODEL, D_MODEL, D_MODEL)
IN_WIDTH = sum(IN_SPLITS)

kernel_name = "hybrid_natten_fnet_ssd_prefix_block"


def rmsnorm(x, w):
    xf = x.astype(jnp.float32)
    y = xf * lax.rsqrt(jnp.mean(xf * xf, axis=-1, keepdims=True) + EPS)
    return (y * w.astype(jnp.float32)).astype(x.dtype)


def split_cols(p):
    offs = np.cumsum(IN_SPLITS)[:-1].tolist()
    return jnp.split(p, offs, axis=-1)


def axial_rope(t):
    L, n = t.shape[1], t.shape[-1]
    quarter = n // 4
    pos = jnp.arange(L)
    inv = ROPE_BASE ** (-jnp.arange(quarter, dtype=jnp.float32) / quarter)

    def rot(u, p):
        ang = p.astype(jnp.float32)[:, None] * inv
        cos = jnp.cos(ang)[None, :, None, :].astype(u.dtype)
        sin = jnp.sin(ang)[None, :, None, :].astype(u.dtype)
        u1, u2 = u[..., :quarter], u[..., quarter:]
        return jnp.concatenate([u1 * cos - u2 * sin, u1 * sin + u2 * cos], axis=-1)

    return jnp.concatenate([rot(t[..., :2 * quarter], pos // GRID_W),
                            rot(t[..., 2 * quarter:], pos % GRID_W)], axis=-1)


def dwconv(u, w, b):
    k = w.shape[0]
    y = lax.conv_general_dilated(u, w[:, None, :], window_strides=(1,), padding=[(k // 2, k // 2)],
                                 dimension_numbers=("NWC", "WIO", "NWC"), feature_group_count=u.shape[-1])
    return y + b


def segsum(a):
    t = a.shape[-1]
    cs = jnp.cumsum(a, axis=-1)
    d = cs[..., :, None] - cs[..., None, :]
    return jnp.where(jnp.tril(jnp.ones((t, t), dtype=bool)), d, -jnp.inf)


def ssd_chunked(xdt, a, bm, cm, init):
    b, L, g, k, p = xdt.shape
    nc = L // SSD_CHUNK
    x = xdt.reshape(b, nc, SSD_CHUNK, g, k, p)
    A = a.astype(jnp.float32).reshape(b, nc, SSD_CHUNK, g, k).transpose(0, 3, 4, 1, 2)
    Bc = bm.reshape(b, nc, SSD_CHUNK, g, -1)
    Cc = cm.reshape(b, nc, SSD_CHUNK, g, -1)
    a_cs = jnp.cumsum(A, axis=-1)
    lmat = jnp.exp(segsum(A))
    y_diag = jnp.einsum("bclgn,bcsgn,bgkcls,bcsgkp->bclgkp", Cc, Bc, lmat, x)
    decay_states = jnp.exp(a_cs[..., -1:] - a_cs)
    states = jnp.einsum("bclgn,bgkcl,bclgkp->bcgkpn", Bc, decay_states, x)
    states = jnp.concatenate([init[:, None].astype(states.dtype), states], axis=1)
    chunk_decay = jnp.exp(segsum(jnp.pad(a_cs[..., -1], ((0, 0), (0, 0), (0, 0), (1, 0)))))
    states = jnp.einsum("bgkzc,bcgkpn->bzgkpn", chunk_decay, states)
    y_off = jnp.einsum("bclgn,bcgkpn,bgkcl->bclgkp", Cc, states[:, :-1], jnp.exp(a_cs))
    y = (y_diag + y_off).reshape(b, L, g, k, p)
    return y, states[:, -1]


def ssd_mixer(xbc_c, dt_c, xbc_l, dt_l, conv_w, conv_b, dt_bias, a_log, d_skip):
    out_dtype = xbc_l.dtype

    def prep(xbc, dt_raw, rope):
        u = jax.nn.silu(dwconv(xbc, conv_w, conv_b))
        xs, bm, cm = jnp.split(u, [SSD_WIDTH, SSD_WIDTH + SSD_GROUPS * SSD_STATE], axis=-1)
        b, L = xs.shape[:2]
        xs = xs.reshape(b, L, SSD_GROUPS, SSD_HPG, SSD_HEAD_DIM)
        bm = bm.reshape(b, L, SSD_GROUPS, SSD_STATE)
        cm = cm.reshape(b, L, SSD_GROUPS, SSD_STATE)
        if rope:
            bm, cm = axial_rope(bm), axial_rope(cm)
        dt = jax.nn.softplus(dt_raw.astype(jnp.float32).reshape(b, L, 2, SSD_GROUPS, SSD_HPG)
                             + dt_bias.astype(jnp.float32).reshape(2, SSD_GROUPS, SSD_HPG))
        return xs, bm, cm, dt

    xc, bc, cc, dtc = prep(xbc_c, dt_c, False)
    xl, bl, cl, dtl = prep(xbc_l, dt_l, True)
    a = -jnp.exp(a_log.astype(jnp.float32)).reshape(2, SSD_GROUPS, SSD_HPG)
    dsk = d_skip.astype(jnp.float32).reshape(SSD_GROUPS, SSD_HPG, 1)
    b = xl.shape[0]
    init = jnp.zeros((b, SSD_GROUPS, SSD_HPG, SSD_HEAD_DIM, SSD_STATE), jnp.float32)
    yc = dsk * xc.astype(jnp.float32)
    yl = dsk * xl.astype(jnp.float32)
    for direction in range(2):
        flip = (lambda t: t[:, ::-1]) if direction == 1 else (lambda t: t)

        def run(xs, bm, cm, dt, s0):
            dtd = dt[:, :, direction]
            y, s = ssd_chunked(flip(xs * dtd[..., None]), flip(dtd * a[direction]), flip(bm), flip(cm), s0)
            return flip(y), s

        y_c, s_c = run(xc, bc, cc, dtc, init)
        y_l, _ = run(xl, bl, cl, dtl, s_c)
        yc = yc + y_c
        yl = yl + y_l
    return (yc.reshape(yc.shape[0], yc.shape[1], SSD_WIDTH).astype(out_dtype),
            yl.reshape(b, yl.shape[1], SSD_WIDTH).astype(out_dtype))


def na_latent(q, k, v, k_ctx, v_ctx, rpb):
    b, L, h, d = q.shape
    rows = L // GRID_W
    win_r = min(NA_WIN_R, rows)
    nblk = GRID_W // NA_QBLK
    scale = d ** -0.5
    qcol = np.arange(GRID_W).reshape(nblk, NA_QBLK)
    qstart = np.clip(qcol - NA_WIN_C // 2, 0, GRID_W - NA_WIN_C)
    kstart = np.clip(qcol[:, 0] - NA_WIN_C // 2, 0, GRID_W - NA_KBLK)
    kcol = (kstart[:, None] + np.arange(NA_KBLK)[None]).astype(np.int32)
    col_mask = ((kcol[:, None, :] >= qstart[..., None]) &
                (kcol[:, None, :] < qstart[..., None] + NA_WIN_C))
    dc = np.clip(kcol[:, None, :] - qcol[..., None] + NA_WIN_C - 1, 0, 2 * NA_WIN_C - 2).astype(np.int32)
    kg = k.reshape(b, rows, GRID_W, h, d)
    vg = v.reshape(b, rows, GRID_W, h, d)
    qg = q.reshape(b, rows, nblk, NA_QBLK, h, d).transpose(1, 0, 2, 3, 4, 5)
    rpb32 = rpb.astype(jnp.float32)
    nwin = win_r * NA_KBLK

    def row_block(args):
        r, q_r = args
        start = jnp.clip(r - win_r // 2, 0, rows - win_r)
        k_r = lax.dynamic_slice_in_dim(kg, start, win_r, axis=1)[:, :, kcol]
        v_r = lax.dynamic_slice_in_dim(vg, start, win_r, axis=1)[:, :, kcol]
        dr = start + jnp.arange(win_r) - r + NA_WIN_R - 1
        bias = rpb32[:, dr][:, :, dc].transpose(0, 2, 3, 1, 4)
        s_w = jnp.einsum("bjqhd,bwjkhd->bhjqwk", q_r, k_r).astype(jnp.float32) * scale + bias[None]
        s_w = jnp.where(col_mask[:, :, None, :], s_w, -1e30)
        s_c = jnp.einsum("bjqhd,bchd->bhjqc", q_r, k_ctx).astype(jnp.float32) * scale
        s = jnp.concatenate([s_w.reshape(b, h, nblk, NA_QBLK, nwin), s_c], axis=-1)
        p = jax.nn.softmax(s, axis=-1).astype(v.dtype)
        p_w = p[..., :nwin].reshape(b, h, nblk, NA_QBLK, win_r, NA_KBLK)
        return (jnp.einsum("bhjqwk,bwjkhd->bjqhd", p_w, v_r)
                + jnp.einsum("bhjqc,bchd->bjqhd", p[..., nwin:], v_ctx))

    o = lax.map(row_block, (jnp.arange(rows), qg))
    return o.transpose(1, 0, 2, 3, 4, 5).reshape(b, L, h * d)


def ctx_attention(q, k, v):
    b, n, h, d = q.shape
    s = jnp.einsum("bqhd,bkhd->bhqk", q, k).astype(jnp.float32) * (d ** -0.5)
    p = jax.nn.softmax(s, axis=-1).astype(v.dtype)
    return jnp.einsum("bhqk,bkhd->bqhd", p, v).reshape(b, n, h * d)


def fourier_mix(u, w):
    b, L, _ = u.shape
    ug = u.astype(jnp.float32).reshape(b, L, FOUR_GROUPS, FOUR_GROUP_DIM)
    f = jnp.fft.fft2(ug, axes=(1, 3), norm="ortho").real
    return f.reshape(b, L, FOUR_WIDTH).astype(u.dtype) @ w


def heads(t):
    return t.reshape(t.shape[0], t.shape[1], NA_HEADS, NA_HEAD_DIM)


def layer(xc, xl, c, c_ctx, w_ada, b_ada, norm_w, w_in, rpb, four_w, conv_w, conv_b, dt_bias, a_log, d_skip,
          ssd_norm_w, wb_na, wb_four, wb_ssd, w_out, update_ctx):
    mod_l = jax.nn.silu(c) @ w_ada + b_ada
    mod_c = jax.nn.silu(c_ctx) @ w_ada + b_ada
    sh_l, sc_l, g_l = jnp.split(mod_l[:, None, :], 3, axis=-1)
    sh_c, sc_c, g_c = jnp.split(mod_c, 3, axis=-1)
    hl = rmsnorm(xl, norm_w) * (1 + sc_l) + sh_l
    hc = rmsnorm(xc, norm_w) * (1 + sc_c) + sh_c
    q_l, k_l, v_l, zna_l, uf_l, zf_l, xbc_l, zs_l, dt_l, gna_l, gf_l, gs_l = split_cols(hl @ w_in)
    q_c, k_c, v_c, zna_c, uf_c, zf_c, xbc_c, zs_c, dt_c, gna_c, gf_c, gs_c = split_cols(hc @ w_in)

    def merge(a, za, f, zf, s, zs, ga, gf, gs):
        o_a = (a * jax.nn.silu(za)) @ wb_na
        o_f = (f * jax.nn.silu(zf)) @ wb_four
        o_s = rmsnorm(s * jax.nn.silu(zs), ssd_norm_w) @ wb_ssd
        return (jax.nn.sigmoid(ga) * o_a + jax.nn.sigmoid(gf) * o_f + jax.nn.sigmoid(gs) * o_s) @ w_out

    kc_h, vc_h = heads(k_c), heads(v_c)
    a_l = na_latent(heads(q_l), heads(k_l), heads(v_l), kc_h, vc_h, rpb)
    f_l = fourier_mix(uf_l, four_w)
    s_c, s_l = ssd_mixer(xbc_c, dt_c, xbc_l, dt_l, conv_w, conv_b, dt_bias, a_log, d_skip)
    xl_new = xl + g_l * merge(a_l, zna_l, f_l, zf_l, s_l, zs_l, gna_l, gf_l, gs_l)
    if update_ctx:
        a_c = ctx_attention(heads(q_c), kc_h, vc_h)
        f_c = fourier_mix(uf_c, four_w)
        xc = xc + g_c * merge(a_c, zna_c, f_c, zf_c, s_c, zs_c, gna_c, gf_c, gs_c)
    return xc, xl_new


def setup_inputs(seed: int = 0) -> dict:
    key = jax.random.key(seed)
    ks = jax.random.split(key, 24)

    def nrm(k, shape, s):
        return jax.random.normal(k, shape, jnp.float32) * s

    dt0 = jnp.exp(jax.random.uniform(ks[12], (DEPTH, 2, SSD_HEADS), jnp.float32,
                                     minval=math.log(1e-3), maxval=math.log(1e-1)))
    return {
        "x": nrm(ks[0], (BATCH, SEQ, D_MODEL), 1.0),
        "c": nrm(ks[1], (BATCH, D_MODEL), 1.0),
        "ctx": nrm(ks[2], (BATCH, CTX_LEN, D_MODEL), 1.0),
        "c_ctx": nrm(ks[3], (D_MODEL,), 1.0),
        "w_ada": nrm(ks[4], (DEPTH, D_MODEL, 3 * D_MODEL), 0.5 * D_MODEL ** -0.5),
        "b_ada": nrm(ks[5], (DEPTH, 3 * D_MODEL), 0.02),
        "norm_w": 1.0 + nrm(ks[6], (DEPTH, D_MODEL), 0.05),
        "w_in": nrm(ks[7], (DEPTH, D_MODEL, IN_WIDTH), D_MODEL ** -0.5),
        "na_rpb": nrm(ks[8], (DEPTH, NA_HEADS, 2 * NA_WIN_R - 1, 2 * NA_WIN_C - 1), 0.05),
        "four_w": nrm(ks[9], (DEPTH, FOUR_WIDTH, FOUR_WIDTH), FOUR_WIDTH ** -0.5),
        "ssd_conv_w": nrm(ks[10], (DEPTH, SSD_CONV, SSD_CONV_CH), SSD_CONV ** -0.5),
        "ssd_conv_b": nrm(ks[11], (DEPTH, SSD_CONV_CH), 0.01),
        "ssd_dt_bias": dt0 + jnp.log(-jnp.expm1(-dt0)),
        "ssd_a_log": jnp.log(jax.random.uniform(ks[13], (DEPTH, 2, SSD_HEADS), jnp.float32, minval=1.0, maxval=16.0)),
        "ssd_d": 1.0 + nrm(ks[14], (DEPTH, SSD_HEADS), 0.1),
        "ssd_norm_w": 1.0 + nrm(ks[15], (DEPTH, SSD_WIDTH), 0.05),
        "wb_na": nrm(ks[16], (DEPTH, NA_WIDTH, D_MODEL), NA_WIDTH ** -0.5),
        "wb_four": nrm(ks[17], (DEPTH, FOUR_WIDTH, D_MODEL), FOUR_WIDTH ** -0.5),
        "wb_ssd": nrm(ks[18], (DEPTH, SSD_WIDTH, D_MODEL), SSD_WIDTH ** -0.5),
        "w_out": nrm(ks[19], (DEPTH, D_MODEL, D_MODEL), D_MODEL ** -0.5),
        "final_norm_w": 1.0 + nrm(ks[20], (D_MODEL,), 0.05),
    }


def reference(x, c, ctx, c_ctx, w_ada, b_ada, norm_w, w_in, na_rpb, four_w, ssd_conv_w, ssd_conv_b,
              ssd_dt_bias, ssd_a_log, ssd_d, ssd_norm_w, wb_na, wb_four, wb_ssd, w_out, final_norm_w):
    xc, xl = ctx, x
    for l in range(DEPTH):
        xc, xl = layer(xc, xl, c, c_ctx, w_ada[l], b_ada[l], norm_w[l], w_in[l], na_rpb[l], four_w[l],
                       ssd_conv_w[l], ssd_conv_b[l], ssd_dt_bias[l], ssd_a_log[l], ssd_d[l], ssd_norm_w[l],
                       wb_na[l], wb_four[l], wb_ssd[l], w_out[l], update_ctx=(l < DEPTH - 1))
    return rmsnorm(xl, final_norm_w)
```

```cpp
#include <hip/hip_runtime.h>
#include <hip/hip_cooperative_groups.h>
#include <cstdio>
namespace cg = cooperative_groups;

#define LAS __attribute__((address_space(3)))
typedef unsigned short bf16_t;
typedef short bf16x8 __attribute__((ext_vector_type(8)));
typedef float f32x4 __attribute__((ext_vector_type(4)));
typedef unsigned u32x4 __attribute__((ext_vector_type(4)));
typedef unsigned u32x2 __attribute__((ext_vector_type(2)));

constexpr int NB = 8, SEQ = 2048, CTXL = 256, NLAT = NB * SEQ, NCTX = NB * CTXL, NTOK = NLAT + NCTX;
constexpr int INW = 15392;
constexpr int PW = 14592;
constexpr int CQ = 0, CK = 1024, CZNA = 2048, CUF = 3072, CZF = 4096, CXBC = 5120, CZS = 7168, CGNA = 8192, CDT = 14336;
constexpr int CA1 = CQ, CA2 = CK, CA3 = CUF, CYF = CXBC, CYB = CXBC + 1024;

constexpr size_t OFF_WINT = 0;
constexpr size_t OFF_WVT  = OFF_WINT + (size_t)PW * 2048 * 2;
constexpr size_t OFF_WCAT = OFF_WVT + (size_t)1024 * 2048 * 2;
constexpr size_t OFF_WOUT = OFF_WCAT + (size_t)2048 * 3072 * 2;
constexpr size_t OFF_W2T  = OFF_WOUT + (size_t)2048 * 2048 * 2;
constexpr size_t OFF_P    = OFF_W2T + (size_t)2048 * 1024 * 2;
constexpr size_t OFF_VT   = OFF_P + (size_t)NTOK * PW * 2;
constexpr size_t OFF_R1   = OFF_VT + (size_t)1024 * NTOK * 2;
constexpr size_t OFF_XL   = OFF_R1 + (size_t)NTOK * 2048 * 2;
constexpr size_t OFF_R2   = OFF_XL + (size_t)NTOK * 2048 * 4;
constexpr size_t OFF_DL   = OFF_R2 + (size_t)NTOK * 2048 * 2;
constexpr size_t OFF_DC   = OFF_DL + (size_t)2048 * 4096 * 2;
constexpr size_t OFF_DTV  = OFF_DC + (size_t)256 * 512 * 2;
constexpr size_t OFF_DEC  = OFF_DTV + (size_t)NTOK * 32 * 4;
constexpr size_t OFF_MOD  = OFF_DEC + (size_t)NTOK * 32 * 4;
constexpr size_t WS_END   = OFF_MOD + (size_t)2 * 9 * 6144 * 4;
constexpr size_t TTCTX_OFF = (size_t)8 * 2048 * 2048 * 2;
constexpr int LDS_BYTES = 131072;

struct Params {
    const float *x, *c, *ctx, *c_ctx, *w_ada, *b_ada, *norm_w, *w_in, *rpb, *four_w, *conv_w, *conv_b, *dt_bias, *a_log, *ssd_d,
                *ssd_norm_w, *wb_na, *wb_four, *wb_ssd, *w_out, *final_norm_w;
    float* out; unsigned char* ws;
};

typedef const __attribute__((address_space(4))) Params* KP;
__device__ __forceinline__ float bf2f(unsigned v) { return __uint_as_float(v << 16); }
__device__ __forceinline__ float bflo(unsigned v) { return __uint_as_float(v << 16); }
__device__ __forceinline__ float bfhi(unsigned v) { return __uint_as_float(v & 0xffff0000u); }
__device__ __forceinline__ unsigned cvt_pk_bf16(float lo, float hi) { unsigned r; asm volatile("v_cvt_pk_bf16_f32 %0, %1, %2" : "=v"(r) : "v"(lo), "v"(hi)); return r; }
__device__ __forceinline__ float silu_f(float x) { return x / (1.f + __expf(-x)); }
__device__ __forceinline__ float sigm_f(float x) { return 1.f / (1.f + __expf(-x)); }
__device__ __forceinline__ int opaque_tid() { int t = threadIdx.x; asm volatile("" : "+v"(t)); return t; }
__device__ __forceinline__ KP fresh(KP p) { asm volatile("" : "+s"(p)); return p; }
__device__ __forceinline__ unsigned char* fresh_ws(KP p) { unsigned char* w = p->ws; asm volatile("" : "+s"(w)); return w; }
__device__ __forceinline__ float wave_sum(float v) {
#pragma unroll
    for (int o = 32; o >= 1; o >>= 1) v += __shfl_xor(v, o);
    return v;
}

constexpr int BM = 256, BK = 64, HALF = 128, HTB = HALF * BK * 2, NXCD = 8, WGM = 8;
__device__ __forceinline__ int lds_byte(int r, int c) { const int st = (r >> 4) * 2 + (c >> 5), rr = r & 15, cc = c & 31, ob = rr * 64 + cc * 2; return st * 1024 + (ob ^ (((ob >> 9) & 1) << 5)); }
__device__ __forceinline__ void stage_rc(int b, int& R, int& C) { const int st = b / 1024, sb = b % 1024, swz = sb ^ (((sb >> 9) & 1) << 5); R = (st >> 1) * 16 + swz / 64; C = (st & 1) * 32 + (swz % 64) / 2; }
__device__ __forceinline__ int perm32(int rho) { const int n = rho >> 4, i = rho & 15; return 8 * (i >> 2) + 4 * n + (i & 3); }

struct Unit { const char* a; const char* b; int pm, pn, z; };
struct GSched {
    const char* A; const char* B; unsigned a_tile, b_tile; int az_lin, az_x2, bz_lin; int nM, nN, nZ, G, c;
    __device__ __forceinline__ bool next(int i, Unit& u) const {
        const int ti = i / nZ, z = i - ti * nZ;
        const long L = (long)ti * G + c; const int nwg = nM * nN; if (L >= nwg) return false;
        int wgid = (int)L; { const int q = nwg / NXCD, r = nwg % NXCD, xcd = wgid % NXCD, off = wgid / NXCD; wgid = (xcd < r ? xcd * (q + 1) : r * (q + 1) + (xcd - r) * q) + off; }
        const int nig = WGM * nN, gid = wgid / nig, fm = gid * WGM, gsz = (nM - fm) < WGM ? (nM - fm) : WGM;
        u.pm = fm + ((wgid % nig) % gsz); u.pn = (wgid % nig) / gsz; u.z = z;
        u.a = A + (size_t)u.pm * a_tile + (size_t)(z * az_lin + (z == 2 ? az_x2 : 0));
        u.b = B + (size_t)u.pn * b_tile + (size_t)(z * bz_lin);
        return true;
    }
};
__device__ __forceinline__ GSched make_sched(const void* A, int lda, const void* B, int ldb, int nM, int nN) {
    GSched S; S.A = (const char*)A; S.B = (const char*)B; S.a_tile = (unsigned)(BM * lda * 2); S.b_tile = (unsigned)(BM * ldb * 2);
    S.az_lin = 0; S.az_x2 = 0; S.bz_lin = 0; S.nM = nM; S.nN = nN; S.nZ = 1; S.G = (int)gridDim.x; S.c = (int)blockIdx.x; return S;
}

template <class Epi>
__device__ __forceinline__ void gemm_phase(LAS unsigned char* lds, const int lda, const int ldb, const int K, const GSched& S, const Epi& E) {
    const int tid = opaque_tid(), wid = __builtin_amdgcn_readfirstlane(tid >> 6), lane = tid & 63, wr = wid >> 2, wc = wid & 3, fr = lane & 15, fq = lane >> 4;
    const int nt = K / BK;
    unsigned voffA[2], voffB[2];
#pragma unroll
    for (int i = 0; i < 2; ++i) { int R, C; stage_rc(tid * 16 + i * 8192, R, C); const int Rb = Epi::PERM ? ((R & ~31) + perm32(R & 31)) : R;
        voffA[i] = (unsigned)(R * lda + C) * 2u; voffB[i] = (unsigned)(Rb * ldb + C) * 2u; }
    const size_t kstep = (size_t)(BK * 2);
    const size_t hstepA = (size_t)HALF * lda * 2, hstepB = (size_t)HALF * ldb * 2;
    const unsigned ldsw = (unsigned)wid * 1024u;
    const int aoff = lds_byte(wr * 64 + fr, fq * 8), boff = lds_byte(wc * 32 + fr, fq * 8);
#define PG8_SA(b, h) (((b) * 2 + (h)) * HTB)
#define PG8_SB(b, h) ((4 + (b) * 2 + (h)) * HTB)
#define PG8_STAGE(bufoff, gbase, voff) do { _Pragma("unroll") for (int _i = 0; _i < 2; ++_i) \
        __builtin_amdgcn_global_load_lds((const unsigned*)((const char*)(gbase) + (voff)[_i]), (LAS unsigned*)(lds + (bufoff) + ldsw + _i * 8192), 16, 0, 0); } while (0)
#define PG8_LDA(dst, b, h) do { _Pragma("unroll") for (int m = 0; m < 4; ++m) _Pragma("unroll") for (int k = 0; k < 2; ++k) dst[m][k] = *(const LAS bf16x8*)(lds + PG8_SA(b, h) + aoff + m * 2048 + k * 1024); } while (0)
#define PG8_LDB(dst, b, h) do { _Pragma("unroll") for (int n = 0; n < 2; ++n) _Pragma("unroll") for (int k = 0; k < 2; ++k) dst[n][k] = *(const LAS bf16x8*)(lds + PG8_SB(b, h) + boff + n * 2048 + k * 1024); } while (0)
#define PG8_MMA(ai, bj, At, Bt) do { __builtin_amdgcn_s_setprio(1); _Pragma("unroll") for (int m = 0; m < 4; ++m) _Pragma("unroll") for (int n = 0; n < 2; ++n) _Pragma("unroll") for (int k = 0; k < 2; ++k) \
        acc[ai][bj][m][n] = __builtin_amdgcn_mfma_f32_16x16x32_bf16(Bt[n][k], At[m][k], acc[ai][bj][m][n], 0, 0, 0); __builtin_amdgcn_s_setprio(0); } while (0)
#define PG8_WAIT_V(n) asm volatile("s_waitcnt vmcnt(" #n ")" ::: "memory")
#define PG8_WAIT_L(n) asm volatile("s_waitcnt lgkmcnt(" #n ")" ::: "memory")
#define PG8_BAR __builtin_amdgcn_s_barrier()
#define PG8_SCHED __builtin_amdgcn_sched_barrier(0)
    Unit cur, nxt; int ui = 0;
    if (!S.next(0, cur)) return;
    f32x4 acc[2][2][4][2];
#pragma unroll
    for (int a = 0; a < 2; ++a)
#pragma unroll
        for (int b = 0; b < 2; ++b)
#pragma unroll
            for (int m = 0; m < 4; ++m)
#pragma unroll
                for (int n = 0; n < 2; ++n) acc[a][b][m][n] = (f32x4){0.f, 0.f, 0.f, 0.f};
    bf16x8 At[4][2], B0[2][2], B1[2][2];
    const char* cA = cur.a; const char* cB = cur.b;
    PG8_STAGE(PG8_SB(0, 0), cB, voffB); PG8_STAGE(PG8_SA(0, 0), cA, voffA); PG8_STAGE(PG8_SB(0, 1), cB + hstepB, voffB); PG8_STAGE(PG8_SA(0, 1), cA + hstepA, voffA);
    if (wr == 1) PG8_BAR;
    PG8_WAIT_V(4); PG8_BAR;
    PG8_STAGE(PG8_SB(1, 0), cB + kstep, voffB); PG8_STAGE(PG8_SA(1, 0), cA + kstep, voffA); PG8_STAGE(PG8_SB(1, 1), cB + hstepB + kstep, voffB);
    PG8_WAIT_V(6); PG8_BAR;
    for (;;) {
        const bool has_next = S.next(ui + 1, nxt);
        const char* nA = has_next ? nxt.a : cA; const char* nB = has_next ? nxt.b : cB;
        for (int t = 0; t < nt; t += 2) {
            const bool last = (t == nt - 2);
            const char* a1 = cA + (size_t)(t + 1) * kstep;
            const char* a2 = last ? nA : cA + (size_t)(t + 2) * kstep; const char* b2 = last ? nB : cB + (size_t)(t + 2) * kstep;
            const char* a3 = a2 + kstep; const char* b3 = b2 + kstep;
            PG8_LDB(B0, 0, 0); PG8_SCHED; PG8_LDA(At, 0, 0); PG8_STAGE(PG8_SA(1, 1), a1 + hstepA, voffA);
            PG8_WAIT_L(8); PG8_BAR; PG8_WAIT_L(0); PG8_MMA(0, 0, At, B0); PG8_BAR; PG8_SCHED;
            PG8_LDB(B1, 0, 1); PG8_STAGE(PG8_SB(0, 0), b2, voffB);
            PG8_BAR; PG8_WAIT_L(0); PG8_MMA(0, 1, At, B1); PG8_BAR;
            PG8_LDA(At, 0, 1); PG8_STAGE(PG8_SA(0, 0), a2, voffA);
            PG8_BAR; PG8_WAIT_L(0); PG8_MMA(1, 0, At, B0); PG8_BAR; PG8_SCHED;
            PG8_STAGE(PG8_SB(0, 1), b2 + hstepB, voffB);
            PG8_WAIT_V(6); PG8_BAR; PG8_MMA(1, 1, At, B1); PG8_BAR;
            PG8_LDB(B0, 1, 0); PG8_SCHED; PG8_LDA(At, 1, 0); PG8_STAGE(PG8_SA(0, 1), a2 + hstepA, voffA);
            PG8_WAIT_L(8); PG8_BAR; PG8_WAIT_L(0); PG8_MMA(0, 0, At, B0); PG8_BAR; PG8_SCHED;
            PG8_LDB(B1, 1, 1); PG8_STAGE(PG8_SB(1, 0), b3, voffB);
            PG8_BAR; PG8_WAIT_L(0); PG8_MMA(0, 1, At, B1); PG8_BAR;
            PG8_LDA(At, 1, 1); PG8_STAGE(PG8_SA(1, 0), a3, voffA);
            PG8_BAR; PG8_WAIT_L(0); PG8_MMA(1, 0, At, B0); PG8_BAR; PG8_SCHED;
            PG8_STAGE(PG8_SB(1, 1), b3 + hstepB, voffB);
            PG8_WAIT_V(6); PG8_BAR; PG8_MMA(1, 1, At, B1); PG8_BAR;
        }
        E(acc, cur, wr, wc, fr, fq);
        if (!has_next) break;
#pragma unroll
        for (int a = 0; a < 2; ++a)
#pragma unroll
            for (int b = 0; b < 2; ++b)
#pragma unroll
                for (int m = 0; m < 4; ++m)
#pragma unroll
                    for (int n = 0; n < 2; ++n) acc[a][b][m][n] = (f32x4){0.f, 0.f, 0.f, 0.f};
        cur = nxt; cA = nA; cB = nB; ++ui;
    }
    PG8_WAIT_V(0);
    if (wr == 0) PG8_BAR;
    PG8_BAR;
#undef PG8_SA
#undef PG8_SB
#undef PG8_STAGE
#undef PG8_LDA
#undef PG8_LDB
#undef PG8_MMA
#undef PG8_WAIT_V
#undef PG8_WAIT_L
#undef PG8_BAR
#undef PG8_SCHED
}

struct EpiStore {
    static constexpr bool PERM = true; bf16_t* O; size_t ldc;
    __device__ __forceinline__ void operator()(const f32x4 (&acc)[2][2][4][2], const Unit& u, int wr, int wc, int fr, int fq) const {
        const int row0 = u.pm * BM + wr * 64 + fr, col0 = u.pn * BM + wc * 32 + 8 * fq;
#pragma unroll
        for (int ai = 0; ai < 2; ++ai)
#pragma unroll
            for (int m = 0; m < 4; ++m) { bf16_t* rowp = O + (size_t)(row0 + ai * HALF + m * 16) * ldc + col0;
#pragma unroll
                for (int bj = 0; bj < 2; ++bj) { const f32x4 v0 = acc[ai][bj][m][0], v1 = acc[ai][bj][m][1];
                    u32x4 w; w.x = cvt_pk_bf16(v0[0], v0[1]); w.y = cvt_pk_bf16(v0[2], v0[3]); w.z = cvt_pk_bf16(v1[0], v1[1]); w.w = cvt_pk_bf16(v1[2], v1[3]);
                    *(u32x4*)(rowp + bj * HALF) = w; } }
    }
};
struct EpiTT {
    static constexpr bool PERM = true; bf16_t* TTlat; bf16_t* TTctx;
    __device__ __forceinline__ void operator()(const f32x4 (&acc)[2][2][4][2], const Unit& u, int wr, int wc, int fr, int fq) const {
        const int row0 = u.pm * BM + wr * 64 + fr; const int cw = wc * 32 + 8 * fq;
        bf16_t* base; size_t L;
        if (u.pn < 64) { const int b = u.pn >> 3; L = 2048; base = TTlat + (size_t)b * 2048 * 2048 + (u.pn & 7) * 256 + cw; }
        else { const int b = u.pn - 64; L = 256; base = TTctx + (size_t)b * 2048 * 256 + cw; }
#pragma unroll
        for (int ai = 0; ai < 2; ++ai)
#pragma unroll
            for (int m = 0; m < 4; ++m) { bf16_t* rowp = base + (size_t)(row0 + ai * HALF + m * 16) * L;
#pragma unroll
                for (int bj = 0; bj < 2; ++bj) { const f32x4 v0 = acc[ai][bj][m][0], v1 = acc[ai][bj][m][1];
                    u32x4 w; w.x = cvt_pk_bf16(v0[0], v0[1]); w.y = cvt_pk_bf16(v0[2], v0[3]); w.z = cvt_pk_bf16(v1[0], v1[1]); w.w = cvt_pk_bf16(v1[2], v1[3]);
                    *(u32x4*)(rowp + bj * HALF) = w; } }
    }
};
struct EpiFb {
    static constexpr bool PERM = true; bf16_t* Pm; int tok0; int L;
    __device__ __forceinline__ void operator()(const f32x4 (&acc)[2][2][4][2], const Unit& u, int wr, int wc, int fr, int fq) const {
        const int b = u.pn >> 2, ch0 = (u.pn & 3) * 256 + wc * 32 + 8 * fq;
        const int row0 = u.pm * BM + wr * 64 + fr;
#pragma unroll
        for (int ai = 0; ai < 2; ++ai)
#pragma unroll
            for (int m = 0; m < 4; ++m) { asm volatile("" ::: "memory"); bf16_t* rowp = Pm + (size_t)(tok0 + b * L + row0 + ai * HALF + m * 16) * PW + ch0;
#pragma unroll
                for (int bj = 0; bj < 2; ++bj) { const f32x4 v0 = acc[ai][bj][m][0], v1 = acc[ai][bj][m][1];
                    const u32x4 z = *(const u32x4*)(rowp + CZF + bj * HALF);
                    u32x4 w; w.x = cvt_pk_bf16(v0[0] * silu_f(bflo(z.x)), v0[1] * silu_f(bfhi(z.x))); w.y = cvt_pk_bf16(v0[2] * silu_f(bflo(z.y)), v0[3] * silu_f(bfhi(z.y)));
                    w.z = cvt_pk_bf16(v1[0] * silu_f(bflo(z.z)), v1[1] * silu_f(bfhi(z.z))); w.w = cvt_pk_bf16(v1[2] * silu_f(bflo(z.w)), v1[3] * silu_f(bfhi(z.w)));
                    *(u32x4*)(rowp + CA2 + bj * HALF) = w; } }
    }
};
struct EpiMerge {
    static constexpr bool PERM = true; const bf16_t* Pm; float* scratch; bf16_t* M1;
    __device__ __forceinline__ void operator()(const f32x4 (&acc)[2][2][4][2], const Unit& u, int wr, int wc, int fr, int fq) const {
        const int row0 = u.pm * BM + wr * 64 + fr, col0 = u.pn * BM + wc * 32 + 8 * fq;
        float* sp = scratch + (size_t)blockIdx.x * 65536 + (size_t)opaque_tid() * 4;
        const bf16_t* gp = Pm + (size_t)row0 * PW + CGNA + u.z * 2048 + col0;
        bf16_t* mp = M1 + (size_t)row0 * 2048 + col0;
        const int z = u.z;
#pragma unroll
        for (int ai = 0; ai < 2; ++ai)
#pragma unroll
            for (int m = 0; m < 4; ++m)
#pragma unroll
                for (int bj = 0; bj < 2; ++bj)
#pragma unroll
                    for (int n = 0; n < 2; ++n) { asm volatile("" ::: "memory");
                        const int ro = ai * HALF + m * 16;
                        const f32x4 v = acc[ai][bj][m][n];
                        const u32x2 g = *(const u32x2*)(gp + (size_t)ro * PW + bj * HALF + n * 4);
                        asm volatile("" : "+v"(sp));
                        f32x4 t;
                        t[0] = v[0] * sigm_f(bflo(g.x)); t[1] = v[1] * sigm_f(bfhi(g.x)); t[2] = v[2] * sigm_f(bflo(g.y)); t[3] = v[3] * sigm_f(bfhi(g.y));
                        if (z > 0) t += *(const f32x4*)sp;
                        if (z < 2) *(f32x4*)sp = t;
                        else { u32x2 w; w.x = cvt_pk_bf16(t[0], t[1]); w.y = cvt_pk_bf16(t[2], t[3]); *(u32x2*)(mp + (size_t)ro * 2048 + bj * HALF + n * 4) = w; }
                        sp += 2048; }
    }
};
struct EpiOut {
    static constexpr bool PERM = false; const float* xlat; const float* xctx; float* xo; const float* mod;
    __device__ __forceinline__ void operator()(const f32x4 (&acc)[2][2][4][2], const Unit& u, int wr, int wc, int fr, int fq) const {
        const int row0 = u.pm * BM + wr * 64 + fr, col0 = u.pn * BM + wc * 32 + 4 * fq;
        const int vec = u.pm < 64 ? (u.pm >> 3) : 8;
        const float* src = u.pm < 64 ? xlat : (xctx - (size_t)NLAT * 2048);
        const float* gp = mod + (size_t)vec * 6144 + 4096 + col0;
        f32x4 gv[2][2];
#pragma unroll
        for (int bj = 0; bj < 2; ++bj)
#pragma unroll
            for (int n = 0; n < 2; ++n) gv[bj][n] = *(const f32x4*)(gp + bj * HALF + n * 16);
#pragma unroll
        for (int ai = 0; ai < 2; ++ai)
#pragma unroll
            for (int m = 0; m < 4; ++m) { asm volatile("" ::: "memory"); const size_t ro = (size_t)(row0 + ai * HALF + m * 16) * 2048 + col0;
#pragma unroll
                for (int bj = 0; bj < 2; ++bj)
#pragma unroll
                    for (int n = 0; n < 2; ++n) { const f32x4 xi = *(const f32x4*)(src + ro + bj * HALF + n * 16);
                        *(f32x4*)(xo + ro + bj * HALF + n * 16) = xi + gv[bj][n] * acc[ai][bj][m][n]; } }
    }
};

__device__ __forceinline__ void phase_ada(KP p, unsigned char* smem) {
    p = fresh(p);
    float* s = (float*)smem; float* red = s + 9 * 2048; float* mod = (float*)(fresh_ws(p) + OFF_MOD);
    const int tid = opaque_tid();
    for (int i = tid; i < 9 * 2048; i += 512) { const int v = i >> 11, k = i & 2047; const float cv = v < 8 ? p->c[v * 2048 + k] : p->c_ctx[k]; s[i] = silu_f(cv); }
    __syncthreads();
    for (int u = blockIdx.x; u < 192; u += gridDim.x) {
        const int l = u / 96, cgp = u % 96, cl = tid & 63, ks = tid >> 6;
        const float* w = p->w_ada + (size_t)l * 2048 * 6144 + cgp * 64 + cl;
        float a0 = 0, a1 = 0, a2 = 0, a3 = 0, a4 = 0, a5 = 0, a6 = 0, a7 = 0, a8 = 0;
#pragma unroll 4
        for (int k = ks * 256; k < ks * 256 + 256; ++k) { const float wv = w[(size_t)k * 6144];
            a0 += s[k] * wv; a1 += s[2048 + k] * wv; a2 += s[4096 + k] * wv; a3 += s[6144 + k] * wv; a4 += s[8192 + k] * wv;
            a5 += s[10240 + k] * wv; a6 += s[12288 + k] * wv; a7 += s[14336 + k] * wv; a8 += s[16384 + k] * wv; }
        float* rp = red + ks * 9 * 64 + cl;
        rp[0] = a0; rp[64] = a1; rp[128] = a2; rp[192] = a3; rp[256] = a4; rp[320] = a5; rp[384] = a6; rp[448] = a7; rp[512] = a8;
        __syncthreads();
        for (int i = tid; i < 9 * 64; i += 512) { float t = 0;
#pragma unroll
            for (int k2 = 0; k2 < 8; ++k2) t += red[k2 * 576 + i];
            const int v = i >> 6, col = cgp * 64 + (i & 63); mod[(size_t)(l * 9 + v) * 6144 + col] = t + p->b_ada[l * 6144 + col]; }
        __syncthreads();
    }
}

__device__ __forceinline__ void transpose_job(const float* src, int lds_, int c0, bf16_t* dst, int ldd, int r0, int k0, int ncols, int K, unsigned char* smem, int rot) {
    float* tile = (float*)smem;
    const int tid = opaque_tid(), ntn = (ncols + 63) >> 6, ntk = K >> 6, ntot = ntn * ntk, G = gridDim.x;
    for (int t = (int)((blockIdx.x + G - (rot % G)) % G); t < ntot; t += G) {
        const int tn = t % ntn, tk = t / ntn, n0 = tn * 64, kb = tk * 64;
        { const int kk = tid >> 4, nn = (tid & 15) * 4;
#pragma unroll
          for (int h = 0; h < 2; ++h) { const int k = kk + h * 32; float zz = 0.f; asm volatile("" : "+v"(zz)); f32x4 v = {zz, zz, zz, zz};
              if (n0 + nn < ncols) v = *(const f32x4*)(src + (size_t)(kb + k) * lds_ + c0 + n0 + nn);
              tile[k * 65 + nn] = v[0]; tile[k * 65 + nn + 1] = v[1]; tile[k * 65 + nn + 2] = v[2]; tile[k * 65 + nn + 3] = v[3]; } }
        __syncthreads();
        { const int n = tid >> 3, kq = (tid & 7) * 8;
          if (n0 + n < ncols) { u32x4 w;
              w.x = cvt_pk_bf16(tile[(kq + 0) * 65 + n], tile[(kq + 1) * 65 + n]); w.y = cvt_pk_bf16(tile[(kq + 2) * 65 + n], tile[(kq + 3) * 65 + n]);
              w.z = cvt_pk_bf16(tile[(kq + 4) * 65 + n], tile[(kq + 5) * 65 + n]); w.w = cvt_pk_bf16(tile[(kq + 6) * 65 + n], tile[(kq + 7) * 65 + n]);
              *(u32x4*)(dst + (size_t)(r0 + n0 + n) * ldd + k0 + kb + kq) = w; } }
        __syncthreads();
    }
}

__device__ __forceinline__ void phase_wprep(KP p, int l, unsigned char* smem) {
    p = fresh(p); unsigned char* wsl = fresh_ws(p);
    bf16_t* WinT = (bf16_t*)(wsl + OFF_WINT); bf16_t* WvT = (bf16_t*)(wsl + OFF_WVT); bf16_t* Wcat = (bf16_t*)(wsl + OFF_WCAT);
    bf16_t* Wout = (bf16_t*)(wsl + OFF_WOUT); bf16_t* W2T = (bf16_t*)(wsl + OFF_W2T);
    const float* win = p->w_in + (size_t)l * 2048 * INW;
    for (int jb = 0; jb < 9; ++jb) {
        const float* s_ = win; int ld_ = INW, c0 = 0, ldd = 2048, r0 = 0, k0 = 0, nc = 2048, K = 2048, rot = 0; bf16_t* d_ = WinT;
        switch (jb) {
            case 0: break;
            case 1: c0 = 3072; r0 = 2048; nc = 6144; break;
            case 2: c0 = 9248; r0 = 8192; nc = 6144; break;
            case 3: c0 = 9216; r0 = CDT; nc = 32; break;
            case 4: c0 = 2048; d_ = WvT; nc = 1024; rot = 32; break;
            case 5: s_ = p->wb_na + (size_t)l * 1024 * 2048; ld_ = 2048; d_ = Wcat; ldd = 3072; K = 1024; rot = 64; break;
            case 6: s_ = p->wb_four + (size_t)l * 1024 * 2048; ld_ = 2048; d_ = Wcat; ldd = 3072; k0 = 1024; K = 1024; rot = 64; break;
            case 7: s_ = p->wb_ssd + (size_t)l * 1024 * 2048; ld_ = 2048; d_ = Wcat; ldd = 3072; k0 = 2048; K = 1024; rot = 64; break;
            default: s_ = p->w_out + (size_t)l * 2048 * 2048; ld_ = 2048; d_ = Wout; break;
        }
        transpose_job(s_, ld_, c0, d_, ldd, r0, k0, nc, K, smem, rot);
    }
    { const size_t n16 = (size_t)(PW - CDT - 32) * 2048 * 2 / 16; u32x4* z = (u32x4*)(WinT + (size_t)(CDT + 32) * 2048);
      unsigned zz = 0u; asm volatile("" : "+v"(zz));
      for (size_t i = (size_t)blockIdx.x * 512 + opaque_tid(); i < n16; i += (size_t)gridDim.x * 512) z[i] = (u32x4){zz, zz, zz, zz}; }
    { float* ct = (float*)smem; float* st = ct + 256; const int tid = opaque_tid();
      __syncthreads();
      if (tid < 256) { ct[tid] = cospif((float)tid * (1.f / 128.f)); st[tid] = sinpif((float)tid * (1.f / 128.f)); }
      __syncthreads();
      const float* fw = p->four_w + (size_t)l * 1024 * 1024;
      for (int u = blockIdx.x; u < 256; u += gridDim.x) {
          const int i0 = (u >> 1) * 8, j = (u & 1) * 512 + tid, g = i0 >> 8, c0 = i0 & 255;
          float ac[8], as[8];
#pragma unroll
          for (int e = 0; e < 8; ++e) { ac[e] = 0.f; as[e] = 0.f; }
          for (int k2 = 0; k2 < 256; ++k2) { const float w = fw[(size_t)(g * 256 + k2) * 1024 + j];
#pragma unroll
              for (int e = 0; e < 8; ++e) { const int idx = (k2 * (c0 + e)) & 255; ac[e] += ct[idx] * w; as[e] += st[idx] * w; } }
          u32x4 wc, wsn;
          wc.x = cvt_pk_bf16(ac[0], ac[1]); wc.y = cvt_pk_bf16(ac[2], ac[3]); wc.z = cvt_pk_bf16(ac[4], ac[5]); wc.w = cvt_pk_bf16(ac[6], ac[7]);
          wsn.x = cvt_pk_bf16(as[0], as[1]); wsn.y = cvt_pk_bf16(as[2], as[3]); wsn.z = cvt_pk_bf16(as[4], as[5]); wsn.w = cvt_pk_bf16(as[6], as[7]);
          *(u32x4*)(W2T + (size_t)(j * 2 + 0) * 1024 + i0) = wc; *(u32x4*)(W2T + (size_t)(j * 2 + 1) * 1024 + i0) = wsn; }
      __syncthreads(); }
}

__device__ __forceinline__ void phase_dft(KP p) {
    unsigned char* wsl = fresh_ws(p);
    bf16_t* DL = (bf16_t*)(wsl + OFF_DL); bf16_t* DC = (bf16_t*)(wsl + OFF_DC);
    const size_t gtid = (size_t)blockIdx.x * 512 + opaque_tid(), gstr = (size_t)gridDim.x * 512;
    { const float sc = 0.001381067932f;
      for (size_t it = gtid; it < (size_t)2048 * 4096 / 8; it += gstr) { const int lp = (int)(it >> 9), rem = (int)(it & 511), cs = rem >> 8, l0 = (rem & 255) * 8;
          float v[8];
#pragma unroll
          for (int e = 0; e < 8; ++e) { const int m = (lp * (l0 + e)) & 2047; const float x = (float)m * (1.f / 1024.f); v[e] = cs ? -sc * sinpif(x) : sc * cospif(x); }
          u32x4 w; w.x = cvt_pk_bf16(v[0], v[1]); w.y = cvt_pk_bf16(v[2], v[3]); w.z = cvt_pk_bf16(v[4], v[5]); w.w = cvt_pk_bf16(v[6], v[7]);
          *(u32x4*)(DL + (size_t)lp * 4096 + cs * 2048 + l0) = w; } }
    { const float sc = 0.00390625f;
      for (size_t it = gtid; it < (size_t)256 * 512 / 8; it += gstr) { const int lp = (int)(it >> 6), rem = (int)(it & 63), cs = rem >> 5, l0 = (rem & 31) * 8;
          float v[8];
#pragma unroll
          for (int e = 0; e < 8; ++e) { const int m = (lp * (l0 + e)) & 255; const float x = (float)m * (1.f / 128.f); v[e] = cs ? -sc * sinpif(x) : sc * cospif(x); }
          u32x4 w; w.x = cvt_pk_bf16(v[0], v[1]); w.y = cvt_pk_bf16(v[2], v[3]); w.z = cvt_pk_bf16(v[4], v[5]); w.w = cvt_pk_bf16(v[6], v[7]);
          *(u32x4*)(DC + (size_t)lp * 512 + cs * 256 + l0) = w; } }
}

__device__ __forceinline__ void phase_norm(KP p, int mode) {
    p = fresh(p); unsigned char* wsl = fresh_ws(p); const int tid = opaque_tid();
    const int lane = tid & 63, wv = tid >> 6;
    const float* xl = (const float*)(wsl + OFF_XL); bf16_t* h = (bf16_t*)(wsl + OFF_R1); const float* mod = (const float*)(wsl + OFF_MOD);
    const int ntok = mode == 2 ? NLAT : NTOK;
    for (int tok = blockIdx.x * 8 + wv; tok < ntok; tok += gridDim.x * 8) {
        const float* src = mode == 0 ? (tok < NLAT ? p->x + (size_t)tok * 2048 : p->ctx + (size_t)(tok - NLAT) * 2048) : xl + (size_t)tok * 2048;
        f32x4 v[8]; float ss = 0.f;
#pragma unroll
        for (int i = 0; i < 8; ++i) { v[i] = *(const f32x4*)(src + (i * 64 + lane) * 4); ss += v[i][0] * v[i][0] + v[i][1] * v[i][1] + v[i][2] * v[i][2] + v[i][3] * v[i][3]; }
        ss = wave_sum(ss);
        const float rstd = rsqrtf(ss * (1.f / 2048.f) + 1e-6f);
        if (mode == 2) {
#pragma unroll
            for (int i = 0; i < 8; ++i) { const int c = (i * 64 + lane) * 4; const f32x4 w = *(const f32x4*)(p->final_norm_w + c); *(f32x4*)(p->out + (size_t)tok * 2048 + c) = v[i] * rstd * w; }
        } else {
            const int vec = tok < NLAT ? (tok >> 11) : 8; const float* mp = mod + (size_t)(mode * 9 + vec) * 6144; const float* nw = p->norm_w + mode * 2048;
#pragma unroll
            for (int i = 0; i < 8; ++i) { const int c = (i * 64 + lane) * 4; const f32x4 w = *(const f32x4*)(nw + c), sh = *(const f32x4*)(mp + c), sc = *(const f32x4*)(mp + 2048 + c);
                const f32x4 o = (v[i] * rstd * w) * (sc + 1.f) + sh;
                u32x2 pk; pk.x = cvt_pk_bf16(o[0], o[1]); pk.y = cvt_pk_bf16(o[2], o[3]); *(u32x2*)(h + (size_t)tok * 2048 + c) = pk; }
        }
    }
}

__device__ __forceinline__ void phase_conv(KP p, int layer, unsigned char* smem) {
    float2* tab = (float2*)smem;
    p = fresh(p); unsigned char* wsl = fresh_ws(p);
    const int tid = opaque_tid();
    __syncthreads();
    for (int i = tid; i < 2048; i += 512) { const int pos = i >> 5, jj = i & 31; const float inv = exp2f(-(float)jj * (13.287712379549449f / 32.f)); const float ang = (float)pos * inv; tab[i] = make_float2(cosf(ang), sinf(ang)); }
    __syncthreads();
    const bf16_t* Pm = (const bf16_t*)(wsl + OFF_P); bf16_t* U = (bf16_t*)(wsl + OFF_R1);
    float* dtv = (float*)(wsl + OFF_DTV); float* dec = (float*)(wsl + OFF_DEC);
    const int ch = tid * 4;
    float w[7][4], bias[4];
#pragma unroll
    for (int j = 0; j < 7; ++j) { const f32x4 t = *(const f32x4*)(p->conv_w + ((size_t)layer * 7 + j) * 2048 + ch); w[j][0] = t[0]; w[j][1] = t[1]; w[j][2] = t[2]; w[j][3] = t[3]; }
    { const f32x4 t = *(const f32x4*)(p->conv_b + (size_t)layer * 2048 + ch); bias[0] = t[0]; bias[1] = t[1]; bias[2] = t[2]; bias[3] = t[3]; }
    const bool ropech = ch >= 1024; const int n = (ch - 1024) & 127, half = n >> 6, i64 = n & 63, jj0 = i64 & 31; const bool first = i64 < 32;
    for (int u = blockIdx.x; u < 1152; u += gridDim.x) {
        int tokbase, s0, L; bool lat;
        if (u < 1024) { tokbase = (u >> 7) * 2048; s0 = (u & 127) * 16; L = 2048; lat = true; } else { const int v = u - 1024; tokbase = NLAT + (v >> 4) * 256; s0 = (v & 15) * 16; L = 256; lat = false; }
        float xr[22][4];
#pragma unroll
        for (int i = 0; i < 22; ++i) { const int s = s0 - 3 + i; u32x2 t = {0u, 0u}; if (s >= 0 && s < L) t = *(const u32x2*)(Pm + (size_t)(tokbase + s) * PW + CXBC + ch);
            xr[i][0] = bflo(t.x); xr[i][1] = bfhi(t.x); xr[i][2] = bflo(t.y); xr[i][3] = bfhi(t.y); }
#pragma unroll
        for (int t = 0; t < 16; ++t) { float o[4];
#pragma unroll
            for (int k = 0; k < 4; ++k) { float a = bias[k];
#pragma unroll
                for (int j = 0; j < 7; ++j) a += w[j][k] * xr[t + j][k];
                o[k] = silu_f(a); }
            const int l = s0 + t; const int pos = half ? (l & 63) : (l >> 6);
#pragma unroll
            for (int k = 0; k < 4; ++k) { const float pv = __shfl_xor(o[k], 8);
                if (lat && ropech) { const float2 cs = tab[pos * 32 + jj0 + k]; o[k] = first ? (o[k] * cs.x - pv * cs.y) : (pv * cs.y + o[k] * cs.x); } }
            u32x2 pk; pk.x = cvt_pk_bf16(o[0], o[1]); pk.y = cvt_pk_bf16(o[2], o[3]);
            *(u32x2*)(U + (size_t)(tokbase + l) * 2048 + ch) = pk; }
        { const int t = tid >> 5, dh = tid & 31; const size_t tok = (size_t)(tokbase + s0 + t);
          const float raw = bf2f(Pm[tok * PW + CDT + dh]) + p->dt_bias[layer * 32 + dh];
          const float dt = raw > 20.f ? raw : log1pf(expf(raw)); const float a = -expf(p->a_log[layer * 32 + dh]);
          dtv[tok * 32 + dh] = dt; dec[tok * 32 + dh] = expf(dt * a); }
    }
    __syncthreads();
}

template <bool WIN>
__device__ __forceinline__ void attn_unit(KP p, unsigned char* wsl, int tid, int layer, int b, int h, int r, int j, int qtok0) {
    const int lane = tid & 63, c16 = lane & 15, q4 = lane >> 4;
    bf16_t* Pm = (bf16_t*)(wsl + OFF_P); const bf16_t* VT = (const bf16_t*)(wsl + OFF_VT);
    bf16x8 qf[4];
    { const bf16_t* qp = Pm + (size_t)(qtok0 + c16) * PW + CQ + h * 128 + q4 * 8;
#pragma unroll
      for (int kk = 0; kk < 4; ++kk) qf[kk] = *(const bf16x8*)(qp + kk * 32); }
    const int start = WIN ? min(max(r - 4, 0), 24) : 0;
    const int kstart = WIN ? min(max(j * 16 - 8, 0), 32) : 0;
    const int kc0 = NLAT + b * 256, kw0 = b * 2048 + start * 64 + kstart;
    const float scale = 0.08838834764831845f;
    f32x4 s[16];
    unsigned pkA[16][2]; float mA = -3.0e38f, sumA = 0.f;
#pragma unroll
    for (int t = 0; t < 16; ++t) {
        const bf16_t* kp = Pm + (size_t)(kc0 + t * 16 + c16) * PW + CK + h * 128 + q4 * 8;
        f32x4 a = {0.f, 0.f, 0.f, 0.f};
#pragma unroll
        for (int kk = 0; kk < 4; ++kk) a = __builtin_amdgcn_mfma_f32_16x16x32_bf16(*(const bf16x8*)(kp + kk * 32), qf[kk], a, 0, 0, 0);
#pragma unroll
        for (int i = 0; i < 4; ++i) { a[i] *= scale; mA = fmaxf(mA, a[i]); }
        s[t] = a;
    }
    mA = fmaxf(mA, __shfl_xor(mA, 16)); mA = fmaxf(mA, __shfl_xor(mA, 32));
#pragma unroll
    for (int t = 0; t < 16; ++t) { const float e0 = __expf(s[t][0] - mA), e1 = __expf(s[t][1] - mA), e2 = __expf(s[t][2] - mA), e3 = __expf(s[t][3] - mA);
        sumA += (e0 + e1) + (e2 + e3); pkA[t][0] = cvt_pk_bf16(e0, e1); pkA[t][1] = cvt_pk_bf16(e2, e3); }
    unsigned pkB[WIN ? 16 : 1][2]; float mB = -3.0e38f, sumB = 0.f;
    if (WIN) {
        const int qcol = j * 16 + c16, qstart = min(max(qcol - 8, 0), 48);
#pragma unroll
        for (int t = 0; t < 16; ++t) {
            const int kr = t >> 1, ct = t & 1;
            const bf16_t* kp = Pm + (size_t)(kw0 + kr * 64 + ct * 16 + c16) * PW + CK + h * 128 + q4 * 8;
            f32x4 a = {0.f, 0.f, 0.f, 0.f};
#pragma unroll
            for (int kk = 0; kk < 4; ++kk) a = __builtin_amdgcn_mfma_f32_16x16x32_bf16(*(const bf16x8*)(kp + kk * 32), qf[kk], a, 0, 0, 0);
            const int dr = start + kr - r + 7;
            const float* bp = p->rpb + ((size_t)(layer * 8 + h) * 15 + dr) * 31;
#pragma unroll
            for (int i = 0; i < 4; ++i) { const int kcol = kstart + ct * 16 + q4 * 4 + i; const bool valid = kcol >= qstart && kcol < qstart + 16;
                float v = -1e30f; if (valid) v = a[i] * scale + bp[kcol - qcol + 15];
                a[i] = v; mB = fmaxf(mB, v); }
            s[t] = a;
        }
        mB = fmaxf(mB, __shfl_xor(mB, 16)); mB = fmaxf(mB, __shfl_xor(mB, 32));
#pragma unroll
        for (int t = 0; t < 16; ++t) { const float e0 = __expf(s[t][0] - mB), e1 = __expf(s[t][1] - mB), e2 = __expf(s[t][2] - mB), e3 = __expf(s[t][3] - mB);
            sumB += (e0 + e1) + (e2 + e3); pkB[t][0] = cvt_pk_bf16(e0, e1); pkB[t][1] = cvt_pk_bf16(e2, e3); }
    }
    const float m = WIN ? fmaxf(mA, mB) : mA;
    const float fA = WIN ? __expf(mA - m) : 1.f, fB = WIN ? __expf(mB - m) : 0.f;
    float sum = sumA * fA + sumB * fB;
    sum += __shfl_xor(sum, 16); sum += __shfl_xor(sum, 32);
    const float inv = 1.f / sum, gA = fA * inv, gB = fB * inv;
    bf16_t* orow = Pm + (size_t)(qtok0 + c16) * PW + h * 128 + q4 * 4;
#pragma unroll
    for (int dt = 0; dt < 8; ++dt) {
        const bf16_t* vp = VT + (size_t)(h * 128 + dt * 16 + c16) * NTOK + q4 * 4;
        f32x4 oA = {0.f, 0.f, 0.f, 0.f}, oB = {0.f, 0.f, 0.f, 0.f};
#pragma unroll
        for (int u = 0; u < 8; ++u) {
            const u32x2 va = *(const u32x2*)(vp + kc0 + (2 * u) * 16), vb = *(const u32x2*)(vp + kc0 + (2 * u + 1) * 16);
            const u32x4 vv = {va.x, va.y, vb.x, vb.y}; const u32x4 pp = {pkA[2 * u][0], pkA[2 * u][1], pkA[2 * u + 1][0], pkA[2 * u + 1][1]};
            oA = __builtin_amdgcn_mfma_f32_16x16x32_bf16(__builtin_bit_cast(bf16x8, vv), __builtin_bit_cast(bf16x8, pp), oA, 0, 0, 0); }
        if (WIN) {
#pragma unroll
            for (int u = 0; u < 8; ++u) {
                const u32x2 va = *(const u32x2*)(vp + kw0 + u * 64), vb = *(const u32x2*)(vp + kw0 + u * 64 + 16);
                const u32x4 vv = {va.x, va.y, vb.x, vb.y}; const u32x4 pp = {pkB[WIN ? 2 * u : 0][0], pkB[WIN ? 2 * u : 0][1], pkB[WIN ? 2 * u + 1 : 0][0], pkB[WIN ? 2 * u + 1 : 0][1]};
                oB = __builtin_amdgcn_mfma_f32_16x16x32_bf16(__builtin_bit_cast(bf16x8, vv), __builtin_bit_cast(bf16x8, pp), oB, 0, 0, 0); }
        }
        const u32x2 z = *(const u32x2*)(orow + CZNA + dt * 16);
        const float o0 = oA[0] * gA + oB[0] * gB, o1 = oA[1] * gA + oB[1] * gB, o2 = oA[2] * gA + oB[2] * gB, o3 = oA[3] * gA + oB[3] * gB;
        u32x2 w; w.x = cvt_pk_bf16(o0 * silu_f(bflo(z.x)), o1 * silu_f(bfhi(z.x))); w.y = cvt_pk_bf16(o2 * silu_f(bflo(z.y)), o3 * silu_f(bfhi(z.y)));
        *(u32x2*)(orow + CA1 + dt * 16) = w;
    }
}

__device__ __forceinline__ void phase_attn(KP p, int layer) {
    p = fresh(p); unsigned char* wsl = fresh_ws(p); const int tid = opaque_tid();
    const int wv = tid >> 6;
    for (int bu = blockIdx.x; bu < 1024; bu += gridDim.x) { const int wu = bu * 8 + wv; const int j = wu & 3, r = (wu >> 2) & 31, h = (wu >> 7) & 7, b = wu >> 10;
        attn_unit<true>(p, wsl, tid, layer, b, h, r, j, b * 2048 + r * 64 + j * 16); }
    if (layer == 0)
        for (int bu = blockIdx.x; bu < 128; bu += gridDim.x) { const int wu = bu * 8 + wv; const int qb = wu & 15, h = (wu >> 4) & 7, b = wu >> 7;
            attn_unit<false>(p, wsl, tid, layer, b, h, 0, 0, NLAT + b * 256 + qb * 16); }
}

__device__ __forceinline__ float dpp_sum8(float v) {
    v += __builtin_bit_cast(float, __builtin_amdgcn_update_dpp(0, __builtin_bit_cast(int, v), 0xB1, 0xf, 0xf, false));
    v += __builtin_bit_cast(float, __builtin_amdgcn_update_dpp(0, __builtin_bit_cast(int, v), 0x4E, 0xf, 0xf, false));
    v += __builtin_bit_cast(float, __builtin_amdgcn_update_dpp(0, __builtin_bit_cast(int, v), 0x141, 0xf, 0xf, false));
    return v;
}
__device__ __forceinline__ int scan_tok(int b, int dir, int s) {
    if (s < 256) return NLAT + b * 256 + (dir ? 255 - s : s);
    const int ss = s - 256; return b * 2048 + (dir ? 2047 - ss : ss);
}
__device__ __forceinline__ void phase_scan(KP p, unsigned char* smem) {
    constexpr int BUF = 49408;
    const int tid = opaque_tid(); unsigned char* wsl = fresh_ws(p);
    const bf16_t* U = (const bf16_t*)(wsl + OFF_R1); bf16_t* Pm = (bf16_t*)(wsl + OFF_P);
    const float* dtv = (const float*)(wsl + OFF_DTV); const float* decg = (const float*)(wsl + OFF_DEC);
    for (int u = blockIdx.x; u < 256; u += gridDim.x) {
        const int b = u >> 5, dir = (u >> 4) & 1, head = u & 15, g = head >> 2, dh = dir * 16 + head;
        const int ycol = (dir ? CYB : CYF) + head * 64;
        const int tt = tid >> 4, pc = tid & 15, tx = tid >> 3, px = tid & 7;
        const int pp = tid >> 3, ns = tid & 7;
        float hst[16];
#pragma unroll
        for (int i = 0; i < 16; ++i) hst[i] = 0.f;
        u32x4 rb, rc, rx = {0u, 0u, 0u, 0u}; float rdt = 0.f, rdec = 0.f;
        __syncthreads();
        { const int tokB = scan_tok(b, dir, tt); rb = *(const u32x4*)(U + (size_t)tokB * 2048 + 1024 + g * 128 + pc * 8); rc = *(const u32x4*)(U + (size_t)tokB * 2048 + 1536 + g * 128 + pc * 8);
          if (tid < 256) { const int tokX = scan_tok(b, dir, tx); rx = *(const u32x4*)(U + (size_t)tokX * 2048 + head * 64 + px * 8); rdt = dtv[(size_t)tokX * 32 + dh]; }
          if (tid < 32) rdec = decg[(size_t)scan_tok(b, dir, tid) * 32 + dh]; }
#define SCAN_WRITE(bufi) do { float* Bf = (float*)(smem + (bufi) * BUF); float* Cf = Bf + 4096; float* Xf = Cf + 4096; float* Dc = Xf + 4096; \
            *(f32x4*)(Bf + tt * 128 + pc * 8) = (f32x4){bflo(rb.x), bfhi(rb.x), bflo(rb.y), bfhi(rb.y)}; *(f32x4*)(Bf + tt * 128 + pc * 8 + 4) = (f32x4){bflo(rb.z), bfhi(rb.z), bflo(rb.w), bfhi(rb.w)}; \
            *(f32x4*)(Cf + tt * 128 + pc * 8) = (f32x4){bflo(rc.x), bfhi(rc.x), bflo(rc.y), bfhi(rc.y)}; *(f32x4*)(Cf + tt * 128 + pc * 8 + 4) = (f32x4){bflo(rc.z), bfhi(rc.z), bflo(rc.w), bfhi(rc.w)}; \
            if (tid < 256) { *(f32x4*)(Xf + tx * 64 + px * 8) = (f32x4){bflo(rx.x) * rdt, bfhi(rx.x) * rdt, bflo(rx.y) * rdt, bfhi(rx.y) * rdt}; \
                             *(f32x4*)(Xf + tx * 64 + px * 8 + 4) = (f32x4){bflo(rx.z) * rdt, bfhi(rx.z) * rdt, bflo(rx.w) * rdt, bfhi(rx.w) * rdt}; } \
            if (tid < 32) Dc[tid] = rdec; } while (0)
        SCAN_WRITE(0);
        __syncthreads();
        for (int c = 0; c < 72; ++c) {
            const int cur = c & 1;
            if (c + 1 < 72) { const int sb = (c + 1) * 32;
                const int tokB = scan_tok(b, dir, sb + tt); rb = *(const u32x4*)(U + (size_t)tokB * 2048 + 1024 + g * 128 + pc * 8); rc = *(const u32x4*)(U + (size_t)tokB * 2048 + 1536 + g * 128 + pc * 8);
                if (tid < 256) { const int tokX = scan_tok(b, dir, sb + tx); rx = *(const u32x4*)(U + (size_t)tokX * 2048 + head * 64 + px * 8); rdt = dtv[(size_t)tokX * 32 + dh]; }
                if (tid < 32) rdec = decg[(size_t)scan_tok(b, dir, sb + tid) * 32 + dh]; }
            { const float* Bf = (const float*)(smem + cur * BUF); const float* Cf = Bf + 4096; const float* Xf = Cf + 4096; float* Ys = (float*)(Xf + 2048); const float* Dc = Xf + 4096;
              for (int t = 0; t < 32; ++t) {
                  const float dcy = Dc[t], xdt = Xf[t * 64 + pp];
                  const f32x4 b0 = *(const f32x4*)(Bf + t * 128 + ns * 16), b1 = *(const f32x4*)(Bf + t * 128 + ns * 16 + 4), b2 = *(const f32x4*)(Bf + t * 128 + ns * 16 + 8), b3 = *(const f32x4*)(Bf + t * 128 + ns * 16 + 12);
                  const f32x4 c0 = *(const f32x4*)(Cf + t * 128 + ns * 16), c1 = *(const f32x4*)(Cf + t * 128 + ns * 16 + 4), c2 = *(const f32x4*)(Cf + t * 128 + ns * 16 + 8), c3 = *(const f32x4*)(Cf + t * 128 + ns * 16 + 12);
                  float y = 0.f;
#pragma unroll
                  for (int i = 0; i < 4; ++i) { hst[i] = dcy * hst[i] + xdt * b0[i]; y += hst[i] * c0[i]; hst[4 + i] = dcy * hst[4 + i] + xdt * b1[i]; y += hst[4 + i] * c1[i];
                      hst[8 + i] = dcy * hst[8 + i] + xdt * b2[i]; y += hst[8 + i] * c2[i]; hst[12 + i] = dcy * hst[12 + i] + xdt * b3[i]; y += hst[12 + i] * c3[i]; }
                  y = dpp_sum8(y);
                  if (ns == 0) Ys[t * 64 + pp] = y;
              } }
            if (c + 1 < 72) SCAN_WRITE(cur ^ 1);
            __syncthreads();
            if (tid < 256) { const float* Ys = (const float*)(smem + cur * BUF) + 4096 + 4096 + 2048; const int tok = scan_tok(b, dir, c * 32 + tx);
                const f32x4 y0 = *(const f32x4*)(Ys + tx * 64 + px * 8), y1 = *(const f32x4*)(Ys + tx * 64 + px * 8 + 4);
                u32x4 w; w.x = cvt_pk_bf16(y0[0], y0[1]); w.y = cvt_pk_bf16(y0[2], y0[3]); w.z = cvt_pk_bf16(y1[0], y1[1]); w.w = cvt_pk_bf16(y1[2], y1[3]);
                *(u32x4*)(Pm + (size_t)tok * PW + ycol + px * 8) = w; }
        }
#undef SCAN_WRITE
        __syncthreads();
    }
}

__device__ __forceinline__ void phase_ssd_final(KP p, int layer, int ntok) {
    p = fresh(p); unsigned char* wsl = fresh_ws(p); const int tid = opaque_tid();
    const int lane = tid & 63, wv = tid >> 6;
    const bf16_t* U = (const bf16_t*)(wsl + OFF_R1); bf16_t* Pm = (bf16_t*)(wsl + OFF_P);
    const int ch = lane * 16; const float dsk = p->ssd_d[layer * 16 + (lane >> 2)];
    for (int tok = blockIdx.x * 8 + wv; tok < ntok; tok += gridDim.x * 8) {
        bf16_t* row = Pm + (size_t)tok * PW;
        float ys[16]; float ss = 0.f;
#pragma unroll
        for (int hh = 0; hh < 2; ++hh) {
            const u32x4 xv = *(const u32x4*)(U + (size_t)tok * 2048 + ch + hh * 8), yf = *(const u32x4*)(row + CYF + ch + hh * 8), yb = *(const u32x4*)(row + CYB + ch + hh * 8), zs = *(const u32x4*)(row + CZS + ch + hh * 8);
            const unsigned xa[4] = {xv.x, xv.y, xv.z, xv.w}, fa[4] = {yf.x, yf.y, yf.z, yf.w}, ba[4] = {yb.x, yb.y, yb.z, yb.w}, za[4] = {zs.x, zs.y, zs.z, zs.w};
#pragma unroll
            for (int e = 0; e < 4; ++e) { const float v0 = (dsk * bflo(xa[e]) + bflo(fa[e]) + bflo(ba[e])) * silu_f(bflo(za[e])); const float v1 = (dsk * bfhi(xa[e]) + bfhi(fa[e]) + bfhi(ba[e])) * silu_f(bfhi(za[e]));
                ys[hh * 8 + e * 2] = v0; ys[hh * 8 + e * 2 + 1] = v1; ss += v0 * v0 + v1 * v1; }
        }
        ss = wave_sum(ss);
        const float rstd = rsqrtf(ss * (1.f / 1024.f) + 1e-6f);
        const float* nw = p->ssd_norm_w + layer * 1024 + ch;
#pragma unroll
        for (int hh = 0; hh < 2; ++hh) { const f32x4 w0 = *(const f32x4*)(nw + hh * 8), w1 = *(const f32x4*)(nw + hh * 8 + 4);
            u32x4 o; o.x = cvt_pk_bf16(ys[hh * 8 + 0] * rstd * w0[0], ys[hh * 8 + 1] * rstd * w0[1]); o.y = cvt_pk_bf16(ys[hh * 8 + 2] * rstd * w0[2], ys[hh * 8 + 3] * rstd * w0[3]);
            o.z = cvt_pk_bf16(ys[hh * 8 + 4] * rstd * w1[0], ys[hh * 8 + 5] * rstd * w1[1]); o.w = cvt_pk_bf16(ys[hh * 8 + 6] * rstd * w1[2], ys[hh * 8 + 7] * rstd * w1[3]);
            *(u32x4*)(row + CA3 + ch + hh * 8) = o; }
    }
}

__global__ void __launch_bounds__(512, 2) fwd_megakernel(Params p_unused) {
    extern __shared__ __attribute__((aligned(16))) unsigned char smem[];
    KP p = (KP)__builtin_amdgcn_kernarg_segment_ptr();
    cg::grid_group grid = cg::this_grid();
    LAS unsigned char* lds = (LAS unsigned char*)smem;
#define WSF unsigned char* ws = fresh_ws(p); bf16_t* Pm = (bf16_t*)(ws + OFF_P); bf16_t* hbuf = (bf16_t*)(ws + OFF_R1); bf16_t* M1 = (bf16_t*)(ws + OFF_R2); \
    bf16_t* TTlat = (bf16_t*)(ws + OFF_R2); bf16_t* TTctx = (bf16_t*)(ws + OFF_R2 + TTCTX_OFF); float* xl = (float*)(ws + OFF_XL); const float* mod = (const float*)(ws + OFF_MOD); \
    (void)Pm; (void)hbuf; (void)M1; (void)TTlat; (void)TTctx; (void)xl; (void)mod;
    for (int l = 0; l < 2; ++l) {
        const int nMt = l == 0 ? 72 : 64;
        if (l == 0) { phase_ada(p, smem); phase_dft(p); }
        phase_wprep(p, l, smem);
        if (l == 0) grid.sync();
        phase_norm(p, l);
        grid.sync();
        { WSF GSched S = make_sched(hbuf, 2048, ws + OFF_WINT, 2048, 72, PW / 256); EpiStore E{Pm, (size_t)PW}; gemm_phase(lds, 2048, 2048, 2048, S, E); }
        { WSF GSched S = make_sched(ws + OFF_WVT, 2048, hbuf, 2048, 4, 72); EpiStore E{(bf16_t*)(ws + OFF_VT), (size_t)NTOK}; gemm_phase(lds, 2048, 2048, 2048, S, E); }
        grid.sync();
        { WSF GSched S = make_sched(ws + OFF_W2T, 1024, Pm + CUF, PW, 8, nMt); EpiTT E{TTlat, TTctx}; gemm_phase(lds, 1024, PW, 1024, S, E); }
        phase_conv(p, l, smem);
        phase_attn(p, l);
        grid.sync();
        { WSF GSched S = make_sched(ws + OFF_DL, 4096, TTlat, 4096, 8, 32); EpiFb E{Pm, 0, 2048}; gemm_phase(lds, 4096, 4096, 4096, S, E); }
        if (l == 0) { WSF GSched S = make_sched(ws + OFF_DC, 512, TTctx, 512, 1, 32); EpiFb E{Pm, NLAT, 256}; gemm_phase(lds, 512, 512, 512, S, E); }
        phase_scan(p, smem);
        grid.sync();
        phase_ssd_final(p, l, l == 0 ? NTOK : NLAT);
        grid.sync();
        { WSF GSched S = make_sched(Pm, PW, ws + OFF_WCAT, 3072, nMt, 8); S.nZ = 3; S.az_lin = CA2 * 2; S.az_x2 = (CA3 - 2 * CA2) * 2; S.bz_lin = 2048;
          EpiMerge E{Pm, (float*)(ws + OFF_R1), M1}; gemm_phase(lds, PW, 3072, 1024, S, E); }
        grid.sync();
        { WSF GSched S = make_sched(M1, 2048, ws + OFF_WOUT, 2048, nMt, 8);
          EpiOut E{l == 0 ? p->x : xl, l == 0 ? p->ctx : xl + (size_t)NLAT * 2048, xl, mod + (size_t)l * 9 * 6144}; gemm_phase(lds, 2048, 2048, 2048, S, E); }
        grid.sync();
    }
    phase_norm(p, 2);
}

extern "C" void kernel_launch(void* const* d_in, const int* in_sizes, int n_in, void* d_out, int out_size, void* d_ws, size_t ws_size, hipStream_t stream) {
    static int grid_blocks = 0;
    if (grid_blocks == 0) {
        if (n_in != 21 || ws_size < WS_END) { fprintf(stderr, "kernel_launch: need 21 inputs and >= %zu bytes of workspace (got %d, %zu)\n", (size_t)WS_END, n_in, ws_size); grid_blocks = -1; return; }
        int dev = 0, cus = 0, per_cu = 0;
        hipGetDevice(&dev); hipDeviceGetAttribute(&cus, hipDeviceAttributeMultiprocessorCount, dev);
        if (hipFuncSetAttribute((const void*)fwd_megakernel, hipFuncAttributeMaxDynamicSharedMemorySize, LDS_BYTES) != hipSuccess) { fprintf(stderr, "kernel_launch: hipFuncSetAttribute failed\n"); grid_blocks = -1; return; }
        if (hipOccupancyMaxActiveBlocksPerMultiprocessor(&per_cu, (const void*)fwd_megakernel, 512, LDS_BYTES) != hipSuccess || per_cu < 1) { fprintf(stderr, "kernel_launch: occupancy query failed (%d)\n", per_cu); per_cu = 1; (void)hipGetLastError(); }
        grid_blocks = cus * 1;
    }
    if (grid_blocks < 0) return;
    Params p{};
    const float** pp = (const float**)&p;
    for (int i = 0; i < 21; ++i) pp[i] = (const float*)d_in[i];
    p.out = (float*)d_out; p.ws = (unsigned char*)d_ws;
    void* args[] = {&p};
    hipError_t e = hipLaunchCooperativeKernel((const void*)fwd_megakernel, dim3(grid_blocks), dim3(512), args, LDS_BYTES, stream);
    if (e != hipSuccess) fprintf(stderr, "cooperative launch failed: %s (grid %d)\n", hipGetErrorString(e), grid_blocks);
}
```

```cpp
#include <hip/hip_runtime.h>
#include <hip/hip_cooperative_groups.h>
#include <cstdio>
namespace cg = cooperative_groups;

#define LAS __attribute__((address_space(3)))
typedef unsigned short bf16_t;
typedef short bf16x8 __attribute__((ext_vector_type(8)));
typedef float f32x4 __attribute__((ext_vector_type(4)));
typedef unsigned u32x4 __attribute__((ext_vector_type(4)));
typedef unsigned u32x2 __attribute__((ext_vector_type(2)));

constexpr int NB = 8, SEQ = 2048, CTXL = 256, NLAT = NB * SEQ, NCTX = NB * CTXL, NTOK = NLAT + NCTX;
constexpr int INW = 15392;
constexpr int PW = 14592;
constexpr int CQ = 0, CK = 1024, CZNA = 2048, CUF = 3072, CZF = 4096, CXBC = 5120, CZS = 7168, CGNA = 8192, CDT = 14336;
constexpr int CA1 = CQ, CA2 = CK, CA3 = CUF, CYF = CXBC, CYB = CXBC + 1024;

constexpr size_t OFF_WINT = 0;
constexpr size_t OFF_WVT  = OFF_WINT + (size_t)PW * 2048 * 2;
constexpr size_t OFF_WCAT = OFF_WVT + (size_t)1024 * 2048 * 2;
constexpr size_t OFF_WOUT = OFF_WCAT + (size_t)2048 * 3072 * 2;
constexpr size_t OFF_W2T  = OFF_WOUT + (size_t)2048 * 2048 * 2;
constexpr size_t OFF_P    = OFF_W2T + (size_t)2048 * 1024 * 2;
constexpr size_t OFF_VT   = OFF_P + (size_t)NTOK * PW * 2;
constexpr size_t OFF_R1   = OFF_VT + (size_t)1024 * NTOK * 2;
constexpr size_t OFF_XL   = OFF_R1 + (size_t)NTOK * 2048 * 2;
constexpr size_t OFF_R2   = OFF_XL + (size_t)NTOK * 2048 * 4;
constexpr size_t OFF_DL   = OFF_R2 + (size_t)NTOK * 2048 * 2;
constexpr size_t OFF_DC   = OFF_DL + (size_t)2048 * 4096 * 2;
constexpr size_t OFF_DTV  = OFF_DC + (size_t)256 * 512 * 2;
constexpr size_t OFF_DEC  = OFF_DTV + (size_t)NTOK * 32 * 4;
constexpr size_t OFF_MOD  = OFF_DEC + (size_t)NTOK * 32 * 4;
constexpr size_t WS_END   = OFF_MOD + (size_t)2 * 9 * 6144 * 4;
constexpr size_t TTCTX_OFF = (size_t)8 * 2048 * 2048 * 2;
constexpr int LDS_BYTES = 131072;

struct Params {
    const float *x, *c, *ctx, *c_ctx, *w_ada, *b_ada, *norm_w, *w_in, *rpb, *four_w, *conv_w, *conv_b, *dt_bias, *a_log, *ssd_d,
                *ssd_norm_w, *wb_na, *wb_four, *wb_ssd, *w_out, *final_norm_w;
    float* out; unsigned char* ws;
};

typedef const __attribute__((address_space(4))) Params* KP;
__device__ __forceinline__ float bf2f(unsigned v) { return __uint_as_float(v << 16); }
__device__ __forceinline__ float bflo(unsigned v) { return __uint_as_float(v << 16); }
__device__ __forceinline__ float bfhi(unsigned v) { return __uint_as_float(v & 0xffff0000u); }
__device__ __forceinline__ unsigned cvt_pk_bf16(float lo, float hi) { unsigned r; asm volatile("v_cvt_pk_bf16_f32 %0, %1, %2" : "=v"(r) : "v"(lo), "v"(hi)); return r; }
__device__ __forceinline__ float silu_f(float x) { return x / (1.f + __expf(-x)); }
__device__ __forceinline__ float sigm_f(float x) { return 1.f / (1.f + __expf(-x)); }
__device__ __forceinline__ int opaque_tid() { int t = threadIdx.x; asm volatile("" : "+v"(t)); return t; }
__device__ __forceinline__ KP fresh(KP p) { asm volatile("" : "+s"(p)); return p; }
__device__ __forceinline__ unsigned char* fresh_ws(KP p) { unsigned char* w = p->ws; asm volatile("" : "+s"(w)); return w; }
__device__ __forceinline__ float wave_sum(float v) {
#pragma unroll
    for (int o = 32; o >= 1; o >>= 1) v += __shfl_xor(v, o);
    return v;
}

constexpr int BM = 256, BK = 64, HALF = 128, HTB = HALF * BK * 2, NXCD = 8, WGM = 8;
__device__ __forceinline__ int lds_byte(int r, int c) { const int st = (r >> 4) * 2 + (c >> 5), rr = r & 15, cc = c & 31, ob = rr * 64 + cc * 2; return st * 1024 + (ob ^ (((ob >> 9) & 1) << 5)); }
__device__ __forceinline__ void stage_rc(int b, int& R, int& C) { const int st = b / 1024, sb = b % 1024, swz = sb ^ (((sb >> 9) & 1) << 5); R = (st >> 1) * 16 + swz / 64; C = (st & 1) * 32 + (swz % 64) / 2; }
__device__ __forceinline__ int perm32(int rho) { const int n = rho >> 4, i = rho & 15; return 8 * (i >> 2) + 4 * n + (i & 3); }

struct Unit { const char* a; const char* b; int pm, pn, z; };
struct GSched {
    const char* A; const char* B; unsigned a_tile, b_tile; int az_lin, az_x2, bz_lin; int nM, nN, nZ, G, c;
    __device__ __forceinline__ bool next(int i, Unit& u) const {
        const int ti = i / nZ, z = i - ti * nZ;
        const long L = (long)ti * G + c; const int nwg = nM * nN; if (L >= nwg) return false;
        int wgid = (int)L; { const int q = nwg / NXCD, r = nwg % NXCD, xcd = wgid % NXCD, off = wgid / NXCD; wgid = (xcd < r ? xcd * (q + 1) : r * (q + 1) + (xcd - r) * q) + off; }
        const int nig = WGM * nN, gid = wgid / nig, fm = gid * WGM, gsz = (nM - fm) < WGM ? (nM - fm) : WGM;
        u.pm = fm + ((wgid % nig) % gsz); u.pn = (wgid % nig) / gsz; u.z = z;
        u.a = A + (size_t)u.pm * a_tile + (size_t)(z * az_lin + (z == 2 ? az_x2 : 0));
        u.b = B + (size_t)u.pn * b_tile + (size_t)(z * bz_lin);
        return true;
    }
};
__device__ __forceinline__ GSched make_sched(const void* A, int lda, const void* B, int ldb, int nM, int nN) {
    GSched S; S.A = (const char*)A; S.B = (const char*)B; S.a_tile = (unsigned)(BM * lda * 2); S.b_tile = (unsigned)(BM * ldb * 2);
    S.az_lin = 0; S.az_x2 = 0; S.bz_lin = 0; S.nM = nM; S.nN = nN; S.nZ = 1; S.G = (int)gridDim.x; S.c = (int)blockIdx.x; return S;
}

template <class Epi>
__device__ __forceinline__ void gemm_phase(LAS unsigned char* lds, const int lda, const int ldb, const int K, const GSched& S, const Epi& E) {
    const int tid = opaque_tid(), wid = __builtin_amdgcn_readfirstlane(tid >> 6), lane = tid & 63, wr = wid >> 2, wc = wid & 3, fr = lane & 15, fq = lane >> 4;
    const int nt = K / BK;
    unsigned voffA[2], voffB[2];
#pragma unroll
    for (int i = 0; i < 2; ++i) { int R, C; stage_rc(tid * 16 + i * 8192, R, C); const int Rb = Epi::PERM ? ((R & ~31) + perm32(R & 31)) : R;
        voffA[i] = (unsigned)(R * lda + C) * 2u; voffB[i] = (unsigned)(Rb * ldb + C) * 2u; }
    const size_t kstep = (size_t)(BK * 2);
    const size_t hstepA = (size_t)HALF * lda * 2, hstepB = (size_t)HALF * ldb * 2;
    const unsigned ldsw = (unsigned)wid * 1024u;
    const int aoff = lds_byte(wr * 64 + fr, fq * 8), boff = lds_byte(wc * 32 + fr, fq * 8);
#define PG8_SA(b, h) (((b) * 2 + (h)) * HTB)
#define PG8_SB(b, h) ((4 + (b) * 2 + (h)) * HTB)
#define PG8_STAGE(bufoff, gbase, voff) do { _Pragma("unroll") for (int _i = 0; _i < 2; ++_i) \
        __builtin_amdgcn_global_load_lds((const unsigned*)((const char*)(gbase) + (voff)[_i]), (LAS unsigned*)(lds + (bufoff) + ldsw + _i * 8192), 16, 0, 0); } while (0)
#define PG8_LDA(dst, b, h) do { _Pragma("unroll") for (int m = 0; m < 4; ++m) _Pragma("unroll") for (int k = 0; k < 2; ++k) dst[m][k] = *(const LAS bf16x8*)(lds + PG8_SA(b, h) + aoff + m * 2048 + k * 1024); } while (0)
#define PG8_LDB(dst, b, h) do { _Pragma("unroll") for (int n = 0; n < 2; ++n) _Pragma("unroll") for (int k = 0; k < 2; ++k) dst[n][k] = *(const LAS bf16x8*)(lds + PG8_SB(b, h) + boff + n * 2048 + k * 1024); } while (0)
#define PG8_MMA(ai, bj, At, Bt) do { __builtin_amdgcn_s_setprio(1); _Pragma("unroll") for (int m = 0; m < 4; ++m) _Pragma("unroll") for (int n = 0; n < 2; ++n) _Pragma("unroll") for (int k = 0; k < 2; ++k) \
        acc[ai][bj][m][n] = __builtin_amdgcn_mfma_f32_16x16x32_bf16(Bt[n][k], At[m][k], acc[ai][bj][m][n], 0, 0, 0); __builtin_amdgcn_s_setprio(0); } while (0)
#define PG8_WAIT_V(n) asm volatile("s_waitcnt vmcnt(" #n ")" ::: "memory")
#define PG8_WAIT_L(n) asm volatile("s_waitcnt lgkmcnt(" #n ")" ::: "memory")
#define PG8_BAR __builtin_amdgcn_s_barrier()
#define PG8_SCHED __builtin_amdgcn_sched_barrier(0)
    Unit cur, nxt; int ui = 0;
    if (!S.next(0, cur)) return;
    f32x4 acc[2][2][4][2];
#pragma unroll
    for (int a = 0; a < 2; ++a)
#pragma unroll
        for (int b = 0; b < 2; ++b)
#pragma unroll
            for (int m = 0; m < 4; ++m)
#pragma unroll
                for (int n = 0; n < 2; ++n) acc[a][b][m][n] = (f32x4){0.f, 0.f, 0.f, 0.f};
    bf16x8 At[4][2], B0[2][2], B1[2][2];
    const char* cA = cur.a; const char* cB = cur.b;
    PG8_STAGE(PG8_SB(0, 0), cB, voffB); PG8_STAGE(PG8_SA(0, 0), cA, voffA); PG8_STAGE(PG8_SB(0, 1), cB + hstepB, voffB); PG8_STAGE(PG8_SA(0, 1), cA + hstepA, voffA);
    if (wr == 1) PG8_BAR;
    PG8_WAIT_V(4); PG8_BAR;
    PG8_STAGE(PG8_SB(1, 0), cB + kstep, voffB); PG8_STAGE(PG8_SA(1, 0), cA + kstep, voffA); PG8_STAGE(PG8_SB(1, 1), cB + hstepB + kstep, voffB);
    PG8_WAIT_V(6); PG8_BAR;
    for (;;) {
        const bool has_next = S.next(ui + 1, nxt);
        const char* nA = has_next ? nxt.a : cA; const char* nB = has_next ? nxt.b : cB;
        for (int t = 0; t < nt; t += 2) {
            const bool last = (t == nt - 2);
            const char* a1 = cA + (size_t)(t + 1) * kstep;
            const char* a2 = last ? nA : cA + (size_t)(t + 2) * kstep; const char* b2 = last ? nB : cB + (size_t)(t + 2) * kstep;
            const char* a3 = a2 + kstep; const char* b3 = b2 + kstep;
            PG8_LDB(B0, 0, 0); PG8_SCHED; PG8_LDA(At, 0, 0); PG8_STAGE(PG8_SA(1, 1), a1 + hstepA, voffA);
            PG8_WAIT_L(8); PG8_BAR; PG8_WAIT_L(0); PG8_MMA(0, 0, At, B0); PG8_BAR; PG8_SCHED;
            PG8_LDB(B1, 0, 1); PG8_STAGE(PG8_SB(0, 0), b2, voffB);
            PG8_BAR; PG8_WAIT_L(0); PG8_MMA(0, 1, At, B1); PG8_BAR;
            PG8_LDA(At, 0, 1); PG8_STAGE(PG8_SA(0, 0), a2, voffA);
            PG8_BAR; PG8_WAIT_L(0); PG8_MMA(1, 0, At, B0); PG8_BAR; PG8_SCHED;
            PG8_STAGE(PG8_SB(0, 1), b2 + hstepB, voffB);
            PG8_WAIT_V(6); PG8_BAR; PG8_MMA(1, 1, At, B1); PG8_BAR;
            PG8_LDB(B0, 1, 0); PG8_SCHED; PG8_LDA(At, 1, 0); PG8_STAGE(PG8_SA(0, 1), a2 + hstepA, voffA);
            PG8_WAIT_L(8); PG8_BAR; PG8_WAIT_L(0); PG8_MMA(0, 0, At, B0); PG8_BAR; PG8_SCHED;
            PG8_LDB(B1, 1, 1); PG8_STAGE(PG8_SB(1, 0), b3, voffB);
            PG8_BAR; PG8_WAIT_L(0); PG8_MMA(0, 1, At, B1); PG8_BAR;
            PG8_LDA(At, 1, 1); PG8_STAGE(PG8_SA(1, 0), a3, voffA);
            PG8_BAR; PG8_WAIT_L(0); PG8_MMA(1, 0, At, B0); PG8_BAR; PG8_SCHED;
            PG8_STAGE(PG8_SB(1, 1), b3 + hstepB, voffB);
            PG8_WAIT_V(6); PG8_BAR; PG8_MMA(1, 1, At, B1); PG8_BAR;
        }
        E(acc, cur, wr, wc, fr, fq);
        if (!has_next) break;
#pragma unroll
        for (int a = 0; a < 2; ++a)
#pragma unroll
            for (int b = 0; b < 2; ++b)
#pragma unroll
                for (int m = 0; m < 4; ++m)
#pragma unroll
                    for (int n = 0; n < 2; ++n) acc[a][b][m][n] = (f32x4){0.f, 0.f, 0.f, 0.f};
        cur = nxt; cA = nA; cB = nB; ++ui;
    }
    PG8_WAIT_V(0);
    if (wr == 0) PG8_BAR;
    PG8_BAR;
#undef PG8_SA
#undef PG8_SB
#undef PG8_STAGE
#undef PG8_LDA
#undef PG8_LDB
#undef PG8_MMA
#undef PG8_WAIT_V
#undef PG8_WAIT_L
#undef PG8_BAR
#undef PG8_SCHED
}

struct EpiStore {
    static constexpr bool PERM = true; bf16_t* O; size_t ldc;
    __device__ __forceinline__ void operator()(const f32x4 (&acc)[2][2][4][2], const Unit& u, int wr, int wc, int fr, int fq) const {
        const int row0 = u.pm * BM + wr * 64 + fr, col0 = u.pn * BM + wc * 32 + 8 * fq;
#pragma unroll
        for (int ai = 0; ai < 2; ++ai)
#pragma unroll
            for (int m = 0; m < 4; ++m) { bf16_t* rowp = O + (size_t)(row0 + ai * HALF + m * 16) * ldc + col0;
#pragma unroll
                for (int bj = 0; bj < 2; ++bj) { const f32x4 v0 = acc[ai][bj][m][0], v1 = acc[ai][bj][m][1];
                    u32x4 w; w.x = cvt_pk_bf16(v0[0], v0[1]); w.y = cvt_pk_bf16(v0[2], v0[3]); w.z = cvt_pk_bf16(v1[0], v1[1]); w.w = cvt_pk_bf16(v1[2], v1[3]);
                    *(u32x4*)(rowp + bj * HALF) = w; } }
    }
};
struct EpiTT {
    static constexpr bool PERM = true; bf16_t* TTlat; bf16_t* TTctx;
    __device__ __forceinline__ void operator()(const f32x4 (&acc)[2][2][4][2], const Unit& u, int wr, int wc, int fr, int fq) const {
        const int row0 = u.pm * BM + wr * 64 + fr; const int cw = wc * 32 + 8 * fq;
        bf16_t* base; size_t L;
        if (u.pn < 64) { const int b = u.pn >> 3; L = 2048; base = TTlat + (size_t)b * 2048 * 2048 + (u.pn & 7) * 256 + cw; }
        else { const int b = u.pn - 64; L = 256; base = TTctx + (size_t)b * 2048 * 256 + cw; }
#pragma unroll
        for (int ai = 0; ai < 2; ++ai)
#pragma unroll
            for (int m = 0; m < 4; ++m) { bf16_t* rowp = base + (size_t)(row0 + ai * HALF + m * 16) * L;
#pragma unroll
                for (int bj = 0; bj < 2; ++bj) { const f32x4 v0 = acc[ai][bj][m][0], v1 = acc[ai][bj][m][1];
                    u32x4 w; w.x = cvt_pk_bf16(v0[0], v0[1]); w.y = cvt_pk_bf16(v0[2], v0[3]); w.z = cvt_pk_bf16(v1[0], v1[1]); w.w = cvt_pk_bf16(v1[2], v1[3]);
                    *(u32x4*)(rowp + bj * HALF) = w; } }
    }
};
struct EpiFb {
    static constexpr bool PERM = true; bf16_t* Pm; int tok0; int L;
    __device__ __forceinline__ void operator()(const f32x4 (&acc)[2][2][4][2], const Unit& u, int wr, int wc, int fr, int fq) const {
        const int b = u.pn >> 2, ch0 = (u.pn & 3) * 256 + wc * 32 + 8 * fq;
        const int row0 = u.pm * BM + wr * 64 + fr;
#pragma unroll
        for (int ai = 0; ai < 2; ++ai)
#pragma unroll
            for (int m = 0; m < 4; ++m) { asm volatile("" ::: "memory"); bf16_t* rowp = Pm + (size_t)(tok0 + b * L + row0 + ai * HALF + m * 16) * PW + ch0;
#pragma unroll
                for (int bj = 0; bj < 2; ++bj) { const f32x4 v0 = acc[ai][bj][m][0], v1 = acc[ai][bj][m][1];
                    const u32x4 z = *(const u32x4*)(rowp + CZF + bj * HALF);
                    u32x4 w; w.x = cvt_pk_bf16(v0[0] * silu_f(bflo(z.x)), v0[1] * silu_f(bfhi(z.x))); w.y = cvt_pk_bf16(v0[2] * silu_f(bflo(z.y)), v0[3] * silu_f(bfhi(z.y)));
                    w.z = cvt_pk_bf16(v1[0] * silu_f(bflo(z.z)), v1[1] * silu_f(bfhi(z.z))); w.w = cvt_pk_bf16(v1[2] * silu_f(bflo(z.w)), v1[3] * silu_f(bfhi(z.w)));
                    *(u32x4*)(rowp + CA2 + bj * HALF) = w; } }
    }
};
struct EpiMerge {
    static constexpr bool PERM = true; const bf16_t* Pm; float* scratch; bf16_t* M1;
    __device__ __forceinline__ void operator()(const f32x4 (&acc)[2][2][4][2], const Unit& u, int wr, int wc, int fr, int fq) const {
        const int row0 = u.pm * BM + wr * 64 + fr, col0 = u.pn * BM + wc * 32 + 8 * fq;
        float* sp = scratch + (size_t)blockIdx.x * 65536 + (size_t)opaque_tid() * 4;
        const bf16_t* gp = Pm + (size_t)row0 * PW + CGNA + u.z * 2048 + col0;
        bf16_t* mp = M1 + (size_t)row0 * 2048 + col0;
        const int z = u.z;
#pragma unroll
        for (int ai = 0; ai < 2; ++ai)
#pragma unroll
            for (int m = 0; m < 4; ++m)
#pragma unroll
                for (int bj = 0; bj < 2; ++bj)
#pragma unroll
                    for (int n = 0; n < 2; ++n) { asm volatile("" ::: "memory");
                        const int ro = ai * HALF + m * 16;
                        const f32x4 v = acc[ai][bj][m][n];
                        const u32x2 g = *(const u32x2*)(gp + (size_t)ro * PW + bj * HALF + n * 4);
                        asm volatile("" : "+v"(sp));
                        f32x4 t;
                        t[0] = v[0] * sigm_f(bflo(g.x)); t[1] = v[1] * sigm_f(bfhi(g.x)); t[2] = v[2] * sigm_f(bflo(g.y)); t[3] = v[3] * sigm_f(bfhi(g.y));
                        if (z > 0) t += *(const f32x4*)sp;
                        if (z < 2) *(f32x4*)sp = t;
                        else { u32x2 w; w.x = cvt_pk_bf16(t[0], t[1]); w.y = cvt_pk_bf16(t[2], t[3]); *(u32x2*)(mp + (size_t)ro * 2048 + bj * HALF + n * 4) = w; }
                        sp += 2048; }
    }
};
struct EpiOut {
    static constexpr bool PERM = false; const float* xlat; const float* xctx; float* xo; const float* mod;
    __device__ __forceinline__ void operator()(const f32x4 (&acc)[2][2][4][2], const Unit& u, int wr, int wc, int fr, int fq) const {
        const int row0 = u.pm * BM + wr * 64 + fr, col0 = u.pn * BM + wc * 32 + 4 * fq;
        const int vec = u.pm < 64 ? (u.pm >> 3) : 8;
        const float* src = u.pm < 64 ? xlat : (xctx - (size_t)NLAT * 2048);
        const float* gp = mod + (size_t)vec * 6144 + 4096 + col0;
        f32x4 gv[2][2];
#pragma unroll
        for (int bj = 0; bj < 2; ++bj)
#pragma unroll
            for (int n = 0; n < 2; ++n) gv[bj][n] = *(const f32x4*)(gp + bj * HALF + n * 16);
#pragma unroll
        for (int ai = 0; ai < 2; ++ai)
#pragma unroll
            for (int m = 0; m < 4; ++m) { asm volatile("" ::: "memory"); const size_t ro = (size_t)(row0 + ai * HALF + m * 16) * 2048 + col0;
#pragma unroll
                for (int bj = 0; bj < 2; ++bj)
#pragma unroll
                    for (int n = 0; n < 2; ++n) { const f32x4 xi = *(const f32x4*)(src + ro + bj * HALF + n * 16);
                        *(f32x4*)(xo + ro + bj * HALF + n * 16) = xi + gv[bj][n] * acc[ai][bj][m][n]; } }
    }
};

__device__ __forceinline__ void phase_ada(KP p, unsigned char* smem) {
    p = fresh(p);
    float* s = (float*)smem; float* red = s + 9 * 2048; float* mod = (float*)(fresh_ws(p) + OFF_MOD);
    const int tid = opaque_tid();
    for (int i = tid; i < 9 * 2048; i += 512) { const int v = i >> 11, k = i & 2047; const float cv = v < 8 ? p->c[v * 2048 + k] : p->c_ctx[k]; s[i] = silu_f(cv); }
    __syncthreads();
    for (int u = blockIdx.x; u < 192; u += gridDim.x) {
        const int l = u / 96, cgp = u % 96, cl = tid & 63, ks = tid >> 6;
        const float* w = p->w_ada + (size_t)l * 2048 * 6144 + cgp * 64 + cl;
        float a0 = 0, a1 = 0, a2 = 0, a3 = 0, a4 = 0, a5 = 0, a6 = 0, a7 = 0, a8 = 0;
#pragma unroll 4
        for (int k = ks * 256; k < ks * 256 + 256; ++k) { const float wv = w[(size_t)k * 6144];
            a0 += s[k] * wv; a1 += s[2048 + k] * wv; a2 += s[4096 + k] * wv; a3 += s[6144 + k] * wv; a4 += s[8192 + k] * wv;
            a5 += s[10240 + k] * wv; a6 += s[12288 + k] * wv; a7 += s[14336 + k] * wv; a8 += s[16384 + k] * wv; }
        float* rp = red + ks * 9 * 64 + cl;
        rp[0] = a0; rp[64] = a1; rp[128] = a2; rp[192] = a3; rp[256] = a4; rp[320] = a5; rp[384] = a6; rp[448] = a7; rp[512] = a8;
        __syncthreads();
        for (int i = tid; i < 9 * 64; i += 512) { float t = 0;
#pragma unroll
            for (int k2 = 0; k2 < 8; ++k2) t += red[k2 * 576 + i];
            const int v = i >> 6, col = cgp * 64 + (i & 63); mod[(size_t)(l * 9 + v) * 6144 + col] = t + p->b_ada[l * 6144 + col]; }
        __syncthreads();
    }
}

__device__ __forceinline__ void transpose_job(const float* src, int lds_, int c0, bf16_t* dst, int ldd, int r0, int k0, int ncols, int K, unsigned char* smem, int rot) {
    float* tile = (float*)smem;
    const int tid = opaque_tid(), ntn = (ncols + 63) >> 6, ntk = K >> 6, ntot = ntn * ntk, G = gridDim.x;
    for (int t = (int)((blockIdx.x + G - (rot % G)) % G); t < ntot; t += G) {
        const int tn = t % ntn, tk = t / ntn, n0 = tn * 64, kb = tk * 64;
        { const int kk = tid >> 4, nn = (tid & 15) * 4;
#pragma unroll
          for (int h = 0; h < 2; ++h) { const int k = kk + h * 32; float zz = 0.f; asm volatile("" : "+v"(zz)); f32x4 v = {zz, zz, zz, zz};
              if (n0 + nn < ncols) v = *(const f32x4*)(src + (size_t)(kb + k) * lds_ + c0 + n0 + nn);
              tile[k * 65 + nn] = v[0]; tile[k * 65 + nn + 1] = v[1]; tile[k * 65 + nn + 2] = v[2]; tile[k * 65 + nn + 3] = v[3]; } }
        __syncthreads();
        { const int n = tid >> 3, kq = (tid & 7) * 8;
          if (n0 + n < ncols) { u32x4 w;
              w.x = cvt_pk_bf16(tile[(kq + 0) * 65 + n], tile[(kq + 1) * 65 + n]); w.y = cvt_pk_bf16(tile[(kq + 2) * 65 + n], tile[(kq + 3) * 65 + n]);
              w.z = cvt_pk_bf16(tile[(kq + 4) * 65 + n], tile[(kq + 5) * 65 + n]); w.w = cvt_pk_bf16(tile[(kq + 6) * 65 + n], tile[(kq + 7) * 65 + n]);
              *(u32x4*)(dst + (size_t)(r0 + n0 + n) * ldd + k0 + kb + kq) = w; } }
        __syncthreads();
    }
}

__device__ __forceinline__ void phase_wprep(KP p, int l, unsigned char* smem) {
    p = fresh(p); unsigned char* wsl = fresh_ws(p);
    bf16_t* WinT = (bf16_t*)(wsl + OFF_WINT); bf16_t* WvT = (bf16_t*)(wsl + OFF_WVT); bf16_t* Wcat = (bf16_t*)(wsl + OFF_WCAT);
    bf16_t* Wout = (bf16_t*)(wsl + OFF_WOUT); bf16_t* W2T = (bf16_t*)(wsl + OFF_W2T);
    const float* win = p->w_in + (size_t)l * 2048 * INW;
    for (int jb = 0; jb < 9; ++jb) {
        const float* s_ = win; int ld_ = INW, c0 = 0, ldd = 2048, r0 = 0, k0 = 0, nc = 2048, K = 2048, rot = 0; bf16_t* d_ = WinT;
        switch (jb) {
            case 0: break;
            case 1: c0 = 3072; r0 = 2048; nc = 6144; break;
            case 2: c0 = 9248; r0 = 8192; nc = 6144; break;
            case 3: c0 = 9216; r0 = CDT; nc = 32; break;
            case 4: c0 = 2048; d_ = WvT; nc = 1024; rot = 32; break;
            case 5: s_ = p->wb_na + (size_t)l * 1024 * 2048; ld_ = 2048; d_ = Wcat; ldd = 3072; K = 1024; rot = 64; break;
            case 6: s_ = p->wb_four + (size_t)l * 1024 * 2048; ld_ = 2048; d_ = Wcat; ldd = 3072; k0 = 1024; K = 1024; rot = 64; break;
            case 7: s_ = p->wb_ssd + (size_t)l * 1024 * 2048; ld_ = 2048; d_ = Wcat; ldd = 3072; k0 = 2048; K = 1024; rot = 64; break;
            default: s_ = p->w_out + (size_t)l * 2048 * 2048; ld_ = 2048; d_ = Wout; break;
        }
        transpose_job(s_, ld_, c0, d_, ldd, r0, k0, nc, K, smem, rot);
    }
    { const size_t n16 = (size_t)(PW - CDT - 32) * 2048 * 2 / 16; u32x4* z = (u32x4*)(WinT + (size_t)(CDT + 32) * 2048);
      unsigned zz = 0u; asm volatile("" : "+v"(zz));
      for (size_t i = (size_t)blockIdx.x * 512 + opaque_tid(); i < n16; i += (size_t)gridDim.x * 512) z[i] = (u32x4){zz, zz, zz, zz}; }
    { float* ct = (float*)smem; float* st = ct + 256; const int tid = opaque_tid();
      __syncthreads();
      if (tid < 256) { ct[tid] = cospif((float)tid * (1.f / 128.f)); st[tid] = sinpif((float)tid * (1.f / 128.f)); }
      __syncthreads();
      const float* fw = p->four_w + (size_t)l * 1024 * 1024;
      for (int u = blockIdx.x; u < 256; u += gridDim.x) {
          const int i0 = (u >> 1) * 8, j = (u & 1) * 512 + tid, g = i0 >> 8, c0 = i0 & 255;
          float ac[8], as[8];
#pragma unroll
          for (int e = 0; e < 8; ++e) { ac[e] = 0.f; as[e] = 0.f; }
          for (int k2 = 0; k2 < 256; ++k2) { const float w = fw[(size_t)(g * 256 + k2) * 1024 + j];
#pragma unroll
              for (int e = 0; e < 8; ++e) { const int idx = (k2 * (c0 + e)) & 255; ac[e] += ct[idx] * w; as[e] += st[idx] * w; } }
          u32x4 wc, wsn;
          wc.x = cvt_pk_bf16(ac[0], ac[1]); wc.y = cvt_pk_bf16(ac[2], ac[3]); wc.z = cvt_pk_bf16(ac[4], ac[5]); wc.w = cvt_pk_bf16(ac[6], ac[7]);
          wsn.x = cvt_pk_bf16(as[0], as[1]); wsn.y = cvt_pk_bf16(as[2], as[3]); wsn.z = cvt_pk_bf16(as[4], as[5]); wsn.w = cvt_pk_bf16(as[6], as[7]);
          *(u32x4*)(W2T + (size_t)(j * 2 + 0) * 1024 + i0) = wc; *(u32x4*)(W2T + (size_t)(j * 2 + 1) * 1024 + i0) = wsn; }
      __syncthreads(); }
}

__device__ __forceinline__ void phase_dft(KP p) {
    unsigned char* wsl = fresh_ws(p);
    bf16_t* DL = (bf16_t*)(wsl + OFF_DL); bf16_t* DC = (bf16_t*)(wsl + OFF_DC);
    const size_t gtid = (size_t)blockIdx.x * 512 + opaque_tid(), gstr = (size_t)gridDim.x * 512;
    { const float sc = 0.001381067932f;
      for (size_t it = gtid; it < (size_t)2048 * 4096 / 8; it += gstr) { const int lp = (int)(it >> 9), rem = (int)(it & 511), cs = rem >> 8, l0 = (rem & 255) * 8;
          float v[8];
#pragma unroll
          for (int e = 0; e < 8; ++e) { const int m = (lp * (l0 + e)) & 2047; const float x = (float)m * (1.f / 1024.f); v[e] = cs ? -sc * sinpif(x) : sc * cospif(x); }
          u32x4 w; w.x = cvt_pk_bf16(v[0], v[1]); w.y = cvt_pk_bf16(v[2], v[3]); w.z = cvt_pk_bf16(v[4], v[5]); w.w = cvt_pk_bf16(v[6], v[7]);
          *(u32x4*)(DL + (size_t)lp * 4096 + cs * 2048 + l0) = w; } }
    { const float sc = 0.00390625f;
      for (size_t it = gtid; it < (size_t)256 * 512 / 8; it += gstr) { const int lp = (int)(it >> 6), rem = (int)(it & 63), cs = rem >> 5, l0 = (rem & 31) * 8;
          float v[8];
#pragma unroll
          for (int e = 0; e < 8; ++e) { const int m = (lp * (l0 + e)) & 255; const float x = (float)m * (1.f / 128.f); v[e] = cs ? -sc * sinpif(x) : sc * cospif(x); }
          u32x4 w; w.x = cvt_pk_bf16(v[0], v[1]); w.y = cvt_pk_bf16(v[2], v[3]); w.z = cvt_pk_bf16(v[4], v[5]); w.w = cvt_pk_bf16(v[6], v[7]);
          *(u32x4*)(DC + (size_t)lp * 512 + cs * 256 + l0) = w; } }
}

__device__ __forceinline__ void phase_norm(KP p, int mode) {
    p = fresh(p); unsigned char* wsl = fresh_ws(p); const int tid = opaque_tid();
    const int lane = tid & 63, wv = tid >> 6;
    const float* xl = (const float*)(wsl + OFF_XL); bf16_t* h = (bf16_t*)(wsl + OFF_R1); const float* mod = (const float*)(wsl + OFF_MOD);
    const int ntok = mode == 2 ? NLAT : NTOK;
    for (int tok = blockIdx.x * 8 + wv; tok < ntok; tok += gridDim.x * 8) {
        const float* src = mode == 0 ? (tok < NLAT ? p->x + (size_t)tok * 2048 : p->ctx + (size_t)(tok - NLAT) * 2048) : xl + (size_t)tok * 2048;
        f32x4 v[8]; float ss = 0.f;
#pragma unroll
        for (int i = 0; i < 8; ++i) { v[i] = *(const f32x4*)(src + (i * 64 + lane) * 4); ss += v[i][0] * v[i][0] + v[i][1] * v[i][1] + v[i][2] * v[i][2] + v[i][3] * v[i][3]; }
        ss = wave_sum(ss);
        const float rstd = rsqrtf(ss * (1.f / 2048.f) + 1e-6f);
        if (mode == 2) {
#pragma unroll
            for (int i = 0; i < 8; ++i) { const int c = (i * 64 + lane) * 4; const f32x4 w = *(const f32x4*)(p->final_norm_w + c); *(f32x4*)(p->out + (size_t)tok * 2048 + c) = v[i] * rstd * w; }
        } else {
            const int vec = tok < NLAT ? (tok >> 11) : 8; const float* mp = mod + (size_t)(mode * 9 + vec) * 6144; const float* nw = p->norm_w + mode * 2048;
#pragma unroll
            for (int i = 0; i < 8; ++i) { const int c = (i * 64 + lane) * 4; const f32x4 w = *(const f32x4*)(nw + c), sh = *(const f32x4*)(mp + c), sc = *(const f32x4*)(mp + 2048 + c);
                const f32x4 o = (v[i] * rstd * w) * (sc + 1.f) + sh;
                u32x2 pk; pk.x = cvt_pk_bf16(o[0], o[1]); pk.y = cvt_pk_bf16(o[2], o[3]); *(u32x2*)(h + (size_t)tok * 2048 + c) = pk; }
        }
    }
}

__device__ __forceinline__ void phase_conv(KP p, int layer, unsigned char* smem) {
    float2* tab = (float2*)smem;
    p = fresh(p); unsigned char* wsl = fresh_ws(p);
    const int tid = opaque_tid();
    __syncthreads();
    for (int i = tid; i < 2048; i += 512) { const int pos = i >> 5, jj = i & 31; const float inv = exp2f(-(float)jj * (13.287712379549449f / 32.f)); const float ang = (float)pos * inv; tab[i] = make_float2(__cosf(ang), __sinf(ang)); }
    __syncthreads();
    const bf16_t* Pm = (const bf16_t*)(wsl + OFF_P); bf16_t* U = (bf16_t*)(wsl + OFF_R1);
    float* dtv = (float*)(wsl + OFF_DTV); float* dec = (float*)(wsl + OFF_DEC);
    const int ch = tid * 4;
    float w[7][4], bias[4];
#pragma unroll
    for (int j = 0; j < 7; ++j) { const f32x4 t = *(const f32x4*)(p->conv_w + ((size_t)layer * 7 + j) * 2048 + ch); w[j][0] = t[0]; w[j][1] = t[1]; w[j][2] = t[2]; w[j][3] = t[3]; }
    { const f32x4 t = *(const f32x4*)(p->conv_b + (size_t)layer * 2048 + ch); bias[0] = t[0]; bias[1] = t[1]; bias[2] = t[2]; bias[3] = t[3]; }
    const bool ropech = ch >= 1024; const int n = (ch - 1024) & 127, half = n >> 6, i64 = n & 63, jj0 = i64 & 31; const bool first = i64 < 32;
    for (int u = blockIdx.x; u < 1152; u += gridDim.x) {
        int tokbase, s0, L; bool lat;
        if (u < 1024) { tokbase = (u >> 7) * 2048; s0 = (u & 127) * 16; L = 2048; lat = true; } else { const int v = u - 1024; tokbase = NLAT + (v >> 4) * 256; s0 = (v & 15) * 16; L = 256; lat = false; }
        float xr[22][4];
#pragma unroll
        for (int i = 0; i < 22; ++i) { const int s = s0 - 3 + i; u32x2 t = {0u, 0u}; if (s >= 0 && s < L) t = *(const u32x2*)(Pm + (size_t)(tokbase + s) * PW + CXBC + ch);
            xr[i][0] = bflo(t.x); xr[i][1] = bfhi(t.x); xr[i][2] = bflo(t.y); xr[i][3] = bfhi(t.y); }
#pragma unroll
        for (int t = 0; t < 16; ++t) { float o[4];
#pragma unroll
            for (int k = 0; k < 4; ++k) { float a = bias[k];
#pragma unroll
                for (int j = 0; j < 7; ++j) a += w[j][k] * xr[t + j][k];
                o[k] = silu_f(a); }
            const int l = s0 + t; const int pos = half ? (l & 63) : (l >> 6);
#pragma unroll
            for (int k = 0; k < 4; ++k) { const float pv = __shfl_xor(o[k], 8);
                if (lat && ropech) { const float2 cs = tab[pos * 32 + jj0 + k]; o[k] = first ? (o[k] * cs.x - pv * cs.y) : (pv * cs.y + o[k] * cs.x); } }
            u32x2 pk; pk.x = cvt_pk_bf16(o[0], o[1]); pk.y = cvt_pk_bf16(o[2], o[3]);
            *(u32x2*)(U + (size_t)(tokbase + l) * 2048 + ch) = pk; }
        { const int t = tid >> 5, dh = tid & 31; const size_t tok = (size_t)(tokbase + s0 + t);
          const float raw = bf2f(Pm[tok * PW + CDT + dh]) + p->dt_bias[layer * 32 + dh];
          const float ex = __expf(raw); const float dt = raw > 15.f ? raw : (ex < 0.02f ? ex * (1.f - ex * (0.5f - ex * (1.f / 3.f))) : __logf(1.f + ex)); const float a = -__expf(p->a_log[layer * 32 + dh]);
          dtv[tok * 32 + dh] = dt; dec[tok * 32 + dh] = dt * a; }
    }
    __syncthreads();
}

template <bool WIN>
__device__ __forceinline__ void attn_unit(KP p, unsigned char* wsl, int tid, int layer, int b, int h, int r, int j, int qtok0) {
    const int lane = tid & 63, c16 = lane & 15, q4 = lane >> 4;
    bf16_t* Pm = (bf16_t*)(wsl + OFF_P); const bf16_t* VT = (const bf16_t*)(wsl + OFF_VT);
    bf16x8 qf[4];
    { const bf16_t* qp = Pm + (size_t)(qtok0 + c16) * PW + CQ + h * 128 + q4 * 8;
#pragma unroll
      for (int kk = 0; kk < 4; ++kk) qf[kk] = *(const bf16x8*)(qp + kk * 32); }
    const int start = WIN ? min(max(r - 4, 0), 24) : 0;
    const int kstart = WIN ? min(max(j * 16 - 8, 0), 32) : 0;
    const int kc0 = NLAT + b * 256, kw0 = b * 2048 + start * 64 + kstart;
    const float scale = 0.08838834764831845f;
    f32x4 s[16];
    unsigned pkA[16][2]; float mA = -3.0e38f, sumA = 0.f;
#pragma unroll
    for (int t = 0; t < 16; ++t) {
        const bf16_t* kp = Pm + (size_t)(kc0 + t * 16 + c16) * PW + CK + h * 128 + q4 * 8;
        f32x4 a = {0.f, 0.f, 0.f, 0.f};
#pragma unroll
        for (int kk = 0; kk < 4; ++kk) a = __builtin_amdgcn_mfma_f32_16x16x32_bf16(*(const bf16x8*)(kp + kk * 32), qf[kk], a, 0, 0, 0);
#pragma unroll
        for (int i = 0; i < 4; ++i) { a[i] *= scale; mA = fmaxf(mA, a[i]); }
        s[t] = a;
    }
    mA = fmaxf(mA, __shfl_xor(mA, 16)); mA = fmaxf(mA, __shfl_xor(mA, 32));
#pragma unroll
    for (int t = 0; t < 16; ++t) { const float e0 = __expf(s[t][0] - mA), e1 = __expf(s[t][1] - mA), e2 = __expf(s[t][2] - mA), e3 = __expf(s[t][3] - mA);
        sumA += (e0 + e1) + (e2 + e3); pkA[t][0] = cvt_pk_bf16(e0, e1); pkA[t][1] = cvt_pk_bf16(e2, e3); }
    unsigned pkB[WIN ? 16 : 1][2]; float mB = -3.0e38f, sumB = 0.f;
    if (WIN) {
        const int qcol = j * 16 + c16, qstart = min(max(qcol - 8, 0), 48);
#pragma unroll
        for (int t = 0; t < 16; ++t) {
            const int kr = t >> 1, ct = t & 1;
            const bf16_t* kp = Pm + (size_t)(kw0 + kr * 64 + ct * 16 + c16) * PW + CK + h * 128 + q4 * 8;
            f32x4 a = {0.f, 0.f, 0.f, 0.f};
#pragma unroll
            for (int kk = 0; kk < 4; ++kk) a = __builtin_amdgcn_mfma_f32_16x16x32_bf16(*(const bf16x8*)(kp + kk * 32), qf[kk], a, 0, 0, 0);
            const int dr = start + kr - r + 7;
            const float* bp = p->rpb + ((size_t)(layer * 8 + h) * 15 + dr) * 31;
#pragma unroll
            for (int i = 0; i < 4; ++i) { const int kcol = kstart + ct * 16 + q4 * 4 + i; const bool valid = kcol >= qstart && kcol < qstart + 16;
                float v = -1e30f; if (valid) v = a[i] * scale + bp[kcol - qcol + 15];
                a[i] = v; mB = fmaxf(mB, v); }
            s[t] = a;
        }
        mB = fmaxf(mB, __shfl_xor(mB, 16)); mB = fmaxf(mB, __shfl_xor(mB, 32));
#pragma unroll
        for (int t = 0; t < 16; ++t) { const float e0 = __expf(s[t][0] - mB), e1 = __expf(s[t][1] - mB), e2 = __expf(s[t][2] - mB), e3 = __expf(s[t][3] - mB);
            sumB += (e0 + e1) + (e2 + e3); pkB[t][0] = cvt_pk_bf16(e0, e1); pkB[t][1] = cvt_pk_bf16(e2, e3); }
    }
    const float m = WIN ? fmaxf(mA, mB) : mA;
    const float fA = WIN ? __expf(mA - m) : 1.f, fB = WIN ? __expf(mB - m) : 0.f;
    float sum = sumA * fA + sumB * fB;
    sum += __shfl_xor(sum, 16); sum += __shfl_xor(sum, 32);
    const float inv = 1.f / sum, gA = fA * inv, gB = fB * inv;
    bf16_t* orow = Pm + (size_t)(qtok0 + c16) * PW + h * 128 + q4 * 4;
#pragma unroll
    for (int dt = 0; dt < 8; ++dt) {
        const bf16_t* vp = VT + (size_t)(h * 128 + dt * 16 + c16) * NTOK + q4 * 4;
        f32x4 oA = {0.f, 0.f, 0.f, 0.f}, oB = {0.f, 0.f, 0.f, 0.f};
#pragma unroll
        for (int u = 0; u < 8; ++u) {
            const u32x2 va = *(const u32x2*)(vp + kc0 + (2 * u) * 16), vb = *(const u32x2*)(vp + kc0 + (2 * u + 1) * 16);
            const u32x4 vv = {va.x, va.y, vb.x, vb.y}; const u32x4 pp = {pkA[2 * u][0], pkA[2 * u][1], pkA[2 * u + 1][0], pkA[2 * u + 1][1]};
            oA = __builtin_amdgcn_mfma_f32_16x16x32_bf16(__builtin_bit_cast(bf16x8, vv), __builtin_bit_cast(bf16x8, pp), oA, 0, 0, 0); }
        if (WIN) {
#pragma unroll
            for (int u = 0; u < 8; ++u) {
                const u32x2 va = *(const u32x2*)(vp + kw0 + u * 64), vb = *(const u32x2*)(vp + kw0 + u * 64 + 16);
                const u32x4 vv = {va.x, va.y, vb.x, vb.y}; const u32x4 pp = {pkB[WIN ? 2 * u : 0][0], pkB[WIN ? 2 * u : 0][1], pkB[WIN ? 2 * u + 1 : 0][0], pkB[WIN ? 2 * u + 1 : 0][1]};
                oB = __builtin_amdgcn_mfma_f32_16x16x32_bf16(__builtin_bit_cast(bf16x8, vv), __builtin_bit_cast(bf16x8, pp), oB, 0, 0, 0); }
        }
        const u32x2 z = *(const u32x2*)(orow + CZNA + dt * 16);
        const float o0 = oA[0] * gA + oB[0] * gB, o1 = oA[1] * gA + oB[1] * gB, o2 = oA[2] * gA + oB[2] * gB, o3 = oA[3] * gA + oB[3] * gB;
        u32x2 w; w.x = cvt_pk_bf16(o0 * silu_f(bflo(z.x)), o1 * silu_f(bfhi(z.x))); w.y = cvt_pk_bf16(o2 * silu_f(bflo(z.y)), o3 * silu_f(bfhi(z.y)));
        *(u32x2*)(orow + CA1 + dt * 16) = w;
    }
}

__device__ __forceinline__ void phase_attn(KP p, int layer) {
    p = fresh(p); unsigned char* wsl = fresh_ws(p); const int tid = opaque_tid();
    const int wv = tid >> 6;
    for (int bu = blockIdx.x; bu < 1024; bu += gridDim.x) { const int wu = bu * 8 + wv; const int j = wu & 3, r = (wu >> 2) & 31, h = (wu >> 7) & 7, b = wu >> 10;
        attn_unit<true>(p, wsl, tid, layer, b, h, r, j, b * 2048 + r * 64 + j * 16); }
    if (layer == 0)
        for (int bu = blockIdx.x; bu < 128; bu += gridDim.x) { const int wu = bu * 8 + wv; const int qb = wu & 15, h = (wu >> 4) & 7, b = wu >> 7;
            attn_unit<false>(p, wsl, tid, layer, b, h, 0, 0, NLAT + b * 256 + qb * 16); }
}

__device__ __forceinline__ int scan_tok(int b, int dir, int s) {
    if (s < 256) return NLAT + b * 256 + (dir ? 255 - s : s);
    const int ss = s - 256; return b * 2048 + (dir ? 2047 - ss : ss);
}
__device__ __forceinline__ void phase_scan(KP p, unsigned char* smem) {
    constexpr int O_C = 0, O_B = 17408, O_BT = 34816, O_XT = 53248, O_H = 62464, O_CS = 97280, O_DT = 97536;
    const int tid = opaque_tid(); unsigned char* wsl = fresh_ws(p);
    LAS unsigned char* lds = (LAS unsigned char*)smem;
    const bf16_t* U = (const bf16_t*)(wsl + OFF_R1); bf16_t* Pm = (bf16_t*)(wsl + OFF_P);
    const float* dtv = (const float*)(wsl + OFF_DTV); const float* dag = (const float*)(wsl + OFF_DEC);
    const int lane = tid & 63, w = tid >> 6, c16 = lane & 15, q4 = lane >> 4;
    const int it = w >> 1, ptb = (w & 1) * 2;
    for (int u = blockIdx.x; u < 256; u += gridDim.x) {
        const int b = u >> 5, dir = (u >> 4) & 1, head = u & 15, g = head >> 2, dh = dir * 16 + head;
        const int ycol = (dir ? CYB : CYF) + head * 64;
        f32x4 hacc[4];
#pragma unroll
        for (int e = 0; e < 4; ++e) hacc[e] = (f32x4){0.f, 0.f, 0.f, 0.f};
        __syncthreads();
        for (int i = tid; i < 64 * 136 * 2 / 16; i += 512) *(LAS u32x4*)(lds + O_H + i * 16) = (u32x4){0u, 0u, 0u, 0u};
        u32x4 rc[2], rb[2], rx; float rdt = 0.f, rda = 0.f;
#define SCAN_LOAD(chunk) do { const int s0_ = (chunk) * 64; \
            _Pragma("unroll") for (int k_ = 0; k_ < 2; ++k_) { const int id_ = tid + 512 * k_; const size_t tk_ = (size_t)scan_tok(b, dir, s0_ + (id_ >> 4)); \
                rc[k_] = *(const u32x4*)(U + tk_ * 2048 + 1536 + g * 128 + (id_ & 15) * 8); rb[k_] = *(const u32x4*)(U + tk_ * 2048 + 1024 + g * 128 + (id_ & 15) * 8); } \
            { const size_t tk_ = (size_t)scan_tok(b, dir, s0_ + (tid >> 3)); rx = *(const u32x4*)(U + tk_ * 2048 + head * 64 + (tid & 7) * 8); } \
            if (tid < 64) { const size_t tk_ = (size_t)scan_tok(b, dir, s0_ + tid); rdt = dtv[tk_ * 32 + dh]; rda = dag[tk_ * 32 + dh]; } } while (0)
#define SCAN_STORE() do { \
            _Pragma("unroll") for (int k_ = 0; k_ < 2; ++k_) { const int id_ = tid + 512 * k_, row_ = id_ >> 4, pc_ = id_ & 15; \
                *(LAS u32x4*)(lds + O_C + (row_ * 136 + pc_ * 8) * 2) = rc[k_]; *(LAS u32x4*)(lds + O_B + (row_ * 136 + pc_ * 8) * 2) = rb[k_]; \
                const unsigned bw_[4] = {rb[k_].x, rb[k_].y, rb[k_].z, rb[k_].w}; \
                _Pragma("unroll") for (int e_ = 0; e_ < 4; ++e_) { *(LAS bf16_t*)(lds + O_BT + ((pc_ * 8 + 2 * e_) * 72 + row_) * 2) = (bf16_t)(bw_[e_] & 0xffffu); \
                                                                  *(LAS bf16_t*)(lds + O_BT + ((pc_ * 8 + 2 * e_ + 1) * 72 + row_) * 2) = (bf16_t)(bw_[e_] >> 16); } } \
            { const int row_ = tid >> 3, pc_ = tid & 7; const unsigned xw_[4] = {rx.x, rx.y, rx.z, rx.w}; \
              _Pragma("unroll") for (int e_ = 0; e_ < 4; ++e_) { *(LAS bf16_t*)(lds + O_XT + ((pc_ * 8 + 2 * e_) * 72 + row_) * 2) = (bf16_t)(xw_[e_] & 0xffffu); \
                                                                *(LAS bf16_t*)(lds + O_XT + ((pc_ * 8 + 2 * e_ + 1) * 72 + row_) * 2) = (bf16_t)(xw_[e_] >> 16); } } \
            if (tid < 64) { float v_ = rda; \
                _Pragma("unroll") for (int o_ = 1; o_ < 64; o_ <<= 1) { const float t_ = __shfl_up(v_, o_); if (lane >= o_) v_ += t_; } \
                *(LAS float*)(lds + O_CS + tid * 4) = v_; *(LAS float*)(lds + O_DT + tid * 4) = rdt; } } while (0)
        SCAN_LOAD(0);
        SCAN_STORE();
        __syncthreads();
        for (int c = 0; c < 36; ++c) {
            const int cur = c & 1;
            if (c + 1 < 36) SCAN_LOAD(c + 1);
            const LAS unsigned char* Hc = lds + O_H + cur * 17408;
            LAS unsigned char* Hn = lds + O_H + (cur ^ 1) * 17408;
            const int irow = it * 16 + c16;
            const float cs_i = *(const LAS float*)(lds + O_CS + irow * 4);
            const float cs_last = *(const LAS float*)(lds + O_CS + 63 * 4);
            bf16x8 xf[4][2];
#pragma unroll
            for (int pt = 0; pt < 4; ++pt)
#pragma unroll
                for (int uu = 0; uu < 2; ++uu) { const LAS unsigned char* xp = lds + O_XT + ((pt * 16 + c16) * 72 + uu * 32 + q4 * 4) * 2;
                    const u32x2 va = *(const LAS u32x2*)xp, vb = *(const LAS u32x2*)(xp + 32); const u32x4 vv = {va.x, va.y, vb.x, vb.y}; xf[pt][uu] = __builtin_bit_cast(bf16x8, vv); }
            bf16x8 cf[4];
#pragma unroll
            for (int kk = 0; kk < 4; ++kk) cf[kk] = *(const LAS bf16x8*)(lds + O_C + (irow * 136 + kk * 32 + q4 * 8) * 2);
            f32x4 yacc[2];
#pragma unroll
            for (int e = 0; e < 2; ++e) { f32x4 a = {0.f, 0.f, 0.f, 0.f};
#pragma unroll
                for (int kk = 0; kk < 4; ++kk) a = __builtin_amdgcn_mfma_f32_16x16x32_bf16(*(const LAS bf16x8*)(Hc + (((ptb + e) * 16 + c16) * 136 + kk * 32 + q4 * 8) * 2), cf[kk], a, 0, 0, 0);
                yacc[e] = a * __expf(cs_i); }
            unsigned pk[4][2];
#pragma unroll
            for (int jt = 0; jt < 4; ++jt) { pk[jt][0] = 0u; pk[jt][1] = 0u;
                if (jt <= it) { f32x4 a = {0.f, 0.f, 0.f, 0.f};
#pragma unroll
                    for (int kk = 0; kk < 4; ++kk) a = __builtin_amdgcn_mfma_f32_16x16x32_bf16(*(const LAS bf16x8*)(lds + O_B + ((jt * 16 + c16) * 136 + kk * 32 + q4 * 8) * 2), cf[kk], a, 0, 0, 0);
                    const f32x4 csj = *(const LAS f32x4*)(lds + O_CS + (jt * 16 + q4 * 4) * 4), dtj = *(const LAS f32x4*)(lds + O_DT + (jt * 16 + q4 * 4) * 4);
                    float m[4];
#pragma unroll
                    for (int r = 0; r < 4; ++r) { const int j = jt * 16 + q4 * 4 + r; m[r] = (j <= irow) ? a[r] * __expf(cs_i - csj[r]) * dtj[r] : 0.f; }
                    pk[jt][0] = cvt_pk_bf16(m[0], m[1]); pk[jt][1] = cvt_pk_bf16(m[2], m[3]); } }
#pragma unroll
            for (int uu = 0; uu < 2; ++uu)
                if (2 * uu <= it) { const u32x4 mm = {pk[2 * uu][0], pk[2 * uu][1], pk[2 * uu + 1][0], pk[2 * uu + 1][1]}; const bf16x8 mf = __builtin_bit_cast(bf16x8, mm);
#pragma unroll
                    for (int e = 0; e < 2; ++e) { const LAS unsigned char* xp = lds + O_XT + (((ptb + e) * 16 + c16) * 72 + uu * 32 + q4 * 4) * 2;
                        const u32x2 va = *(const LAS u32x2*)xp, vb = *(const LAS u32x2*)(xp + 32); const u32x4 vv = {va.x, va.y, vb.x, vb.y};
                        yacc[e] = __builtin_amdgcn_mfma_f32_16x16x32_bf16(__builtin_bit_cast(bf16x8, vv), mf, yacc[e], 0, 0, 0); } }
            { const size_t tok = (size_t)scan_tok(b, dir, c * 64 + irow);
#pragma unroll
              for (int e = 0; e < 2; ++e) { u32x2 o; o.x = cvt_pk_bf16(yacc[e][0], yacc[e][1]); o.y = cvt_pk_bf16(yacc[e][2], yacc[e][3]);
                  *(u32x2*)(Pm + tok * PW + ycol + (ptb + e) * 16 + q4 * 4) = o; } }
            { const float dl = __expf(cs_last);
#pragma unroll
              for (int pt = 0; pt < 4; ++pt) hacc[pt] = hacc[pt] * dl;
#pragma unroll
              for (int uu = 0; uu < 2; ++uu) {
                  const LAS unsigned char* bp = lds + O_BT + ((w * 16 + c16) * 72 + uu * 32 + q4 * 4) * 2;
                  const u32x2 ba = *(const LAS u32x2*)bp, bb = *(const LAS u32x2*)(bp + 32);
                  const f32x4 cs0 = *(const LAS f32x4*)(lds + O_CS + (uu * 32 + q4 * 4) * 4), cs1 = *(const LAS f32x4*)(lds + O_CS + (uu * 32 + 16 + q4 * 4) * 4);
                  const f32x4 d0 = *(const LAS f32x4*)(lds + O_DT + (uu * 32 + q4 * 4) * 4), d1 = *(const LAS f32x4*)(lds + O_DT + (uu * 32 + 16 + q4 * 4) * 4);
                  u32x4 sb;
                  sb.x = cvt_pk_bf16(bflo(ba.x) * __expf(cs_last - cs0[0]) * d0[0], bfhi(ba.x) * __expf(cs_last - cs0[1]) * d0[1]);
                  sb.y = cvt_pk_bf16(bflo(ba.y) * __expf(cs_last - cs0[2]) * d0[2], bfhi(ba.y) * __expf(cs_last - cs0[3]) * d0[3]);
                  sb.z = cvt_pk_bf16(bflo(bb.x) * __expf(cs_last - cs1[0]) * d1[0], bfhi(bb.x) * __expf(cs_last - cs1[1]) * d1[1]);
                  sb.w = cvt_pk_bf16(bflo(bb.y) * __expf(cs_last - cs1[2]) * d1[2], bfhi(bb.y) * __expf(cs_last - cs1[3]) * d1[3]);
                  const bf16x8 bfr = __builtin_bit_cast(bf16x8, sb);
#pragma unroll
                  for (int pt = 0; pt < 4; ++pt) hacc[pt] = __builtin_amdgcn_mfma_f32_16x16x32_bf16(bfr, xf[pt][uu], hacc[pt], 0, 0, 0); }
#pragma unroll
              for (int pt = 0; pt < 4; ++pt) { u32x2 o; o.x = cvt_pk_bf16(hacc[pt][0], hacc[pt][1]); o.y = cvt_pk_bf16(hacc[pt][2], hacc[pt][3]);
                  *(LAS u32x2*)(Hn + ((pt * 16 + c16) * 136 + w * 16 + q4 * 4) * 2) = o; } }
            __syncthreads();
            if (c + 1 < 36) SCAN_STORE();
            __syncthreads();
        }
#undef SCAN_LOAD
#undef SCAN_STORE
    }
}

__device__ __forceinline__ void phase_ssd_final(KP p, int layer, int ntok) {
    p = fresh(p); unsigned char* wsl = fresh_ws(p); const int tid = opaque_tid();
    const int lane = tid & 63, wv = tid >> 6;
    const bf16_t* U = (const bf16_t*)(wsl + OFF_R1); bf16_t* Pm = (bf16_t*)(wsl + OFF_P);
    const int ch = lane * 16; const float dsk = p->ssd_d[layer * 16 + (lane >> 2)];
    for (int tok = blockIdx.x * 8 + wv; tok < ntok; tok += gridDim.x * 8) {
        bf16_t* row = Pm + (size_t)tok * PW;
        float ys[16]; float ss = 0.f;
#pragma unroll
        for (int hh = 0; hh < 2; ++hh) {
            const u32x4 xv = *(const u32x4*)(U + (size_t)tok * 2048 + ch + hh * 8), yf = *(const u32x4*)(row + CYF + ch + hh * 8), yb = *(const u32x4*)(row + CYB + ch + hh * 8), zs = *(const u32x4*)(row + CZS + ch + hh * 8);
            const unsigned xa[4] = {xv.x, xv.y, xv.z, xv.w}, fa[4] = {yf.x, yf.y, yf.z, yf.w}, ba[4] = {yb.x, yb.y, yb.z, yb.w}, za[4] = {zs.x, zs.y, zs.z, zs.w};
#pragma unroll
            for (int e = 0; e < 4; ++e) { const float v0 = (dsk * bflo(xa[e]) + bflo(fa[e]) + bflo(ba[e])) * silu_f(bflo(za[e])); const float v1 = (dsk * bfhi(xa[e]) + bfhi(fa[e]) + bfhi(ba[e])) * silu_f(bfhi(za[e]));
                ys[hh * 8 + e * 2] = v0; ys[hh * 8 + e * 2 + 1] = v1; ss += v0 * v0 + v1 * v1; }
        }
        ss = wave_sum(ss);
        const float rstd = rsqrtf(ss * (1.f / 1024.f) + 1e-6f);
        const float* nw = p->ssd_norm_w + layer * 1024 + ch;
#pragma unroll
        for (int hh = 0; hh < 2; ++hh) { const f32x4 w0 = *(const f32x4*)(nw + hh * 8), w1 = *(const f32x4*)(nw + hh * 8 + 4);
            u32x4 o; o.x = cvt_pk_bf16(ys[hh * 8 + 0] * rstd * w0[0], ys[hh * 8 + 1] * rstd * w0[1]); o.y = cvt_pk_bf16(ys[hh * 8 + 2] * rstd * w0[2], ys[hh * 8 + 3] * rstd * w0[3]);
            o.z = cvt_pk_bf16(ys[hh * 8 + 4] * rstd * w1[0], ys[hh * 8 + 5] * rstd * w1[1]); o.w = cvt_pk_bf16(ys[hh * 8 + 6] * rstd * w1[2], ys[hh * 8 + 7] * rstd * w1[3]);
            *(u32x4*)(row + CA3 + ch + hh * 8) = o; }
    }
}

__global__ void __launch_bounds__(512, 2) fwd_megakernel(Params p_unused) {
    extern __shared__ __attribute__((aligned(16))) unsigned char smem[];
    KP p = (KP)__builtin_amdgcn_kernarg_segment_ptr();
    cg::grid_group grid = cg::this_grid();
    LAS unsigned char* lds = (LAS unsigned char*)smem;
#define WSF unsigned char* ws = fresh_ws(p); bf16_t* Pm = (bf16_t*)(ws + OFF_P); bf16_t* hbuf = (bf16_t*)(ws + OFF_R1); bf16_t* M1 = (bf16_t*)(ws + OFF_R2); \
    bf16_t* TTlat = (bf16_t*)(ws + OFF_R2); bf16_t* TTctx = (bf16_t*)(ws + OFF_R2 + TTCTX_OFF); float* xl = (float*)(ws + OFF_XL); const float* mod = (const float*)(ws + OFF_MOD); \
    (void)Pm; (void)hbuf; (void)M1; (void)TTlat; (void)TTctx; (void)xl; (void)mod;
    for (int l = 0; l < 2; ++l) {
        const int nMt = l == 0 ? 72 : 64;
        if (l == 0) { phase_ada(p, smem); phase_dft(p); }
        phase_wprep(p, l, smem);
        if (l == 0) grid.sync();
        phase_norm(p, l);
        grid.sync();
        { WSF GSched S = make_sched(hbuf, 2048, ws + OFF_WINT, 2048, 72, PW / 256); EpiStore E{Pm, (size_t)PW}; gemm_phase(lds, 2048, 2048, 2048, S, E); }
        { WSF GSched S = make_sched(ws + OFF_WVT, 2048, hbuf, 2048, 4, 72); EpiStore E{(bf16_t*)(ws + OFF_VT), (size_t)NTOK}; gemm_phase(lds, 2048, 2048, 2048, S, E); }
        grid.sync();
        { WSF GSched S = make_sched(ws + OFF_W2T, 1024, Pm + CUF, PW, 8, nMt); EpiTT E{TTlat, TTctx}; gemm_phase(lds, 1024, PW, 1024, S, E); }
        phase_conv(p, l, smem);
        phase_attn(p, l);
        grid.sync();
        { WSF GSched S = make_sched(ws + OFF_DL, 4096, TTlat, 4096, 8, 32); EpiFb E{Pm, 0, 2048}; gemm_phase(lds, 4096, 4096, 4096, S, E); }
        if (l == 0) { WSF GSched S = make_sched(ws + OFF_DC, 512, TTctx, 512, 1, 32); EpiFb E{Pm, NLAT, 256}; gemm_phase(lds, 512, 512, 512, S, E); }
        phase_scan(p, smem);
        grid.sync();
        phase_ssd_final(p, l, l == 0 ? NTOK : NLAT);
        grid.sync();
        { WSF GSched S = make_sched(Pm, PW, ws + OFF_WCAT, 3072, nMt, 8); S.nZ = 3; S.az_lin = CA2 * 2; S.az_x2 = (CA3 - 2 * CA2) * 2; S.bz_lin = 2048;
          EpiMerge E{Pm, (float*)(ws + OFF_R1), M1}; gemm_phase(lds, PW, 3072, 1024, S, E); }
        grid.sync();
        { WSF GSched S = make_sched(M1, 2048, ws + OFF_WOUT, 2048, nMt, 8);
          EpiOut E{l == 0 ? p->x : xl, l == 0 ? p->ctx : xl + (size_t)NLAT * 2048, xl, mod + (size_t)l * 9 * 6144}; gemm_phase(lds, 2048, 2048, 2048, S, E); }
        grid.sync();
    }
    phase_norm(p, 2);
}

extern "C" void kernel_launch(void* const* d_in, const int* in_sizes, int n_in, void* d_out, int out_size, void* d_ws, size_t ws_size, hipStream_t stream) {
    static int grid_blocks = 0;
    if (grid_blocks == 0) {
        if (n_in != 21 || ws_size < WS_END) { fprintf(stderr, "kernel_launch: need 21 inputs and >= %zu bytes of workspace (got %d, %zu)\n", (size_t)WS_END, n_in, ws_size); grid_blocks = -1; return; }
        int dev = 0, cus = 0, per_cu = 0;
        hipGetDevice(&dev); hipDeviceGetAttribute(&cus, hipDeviceAttributeMultiprocessorCount, dev);
        if (hipFuncSetAttribute((const void*)fwd_megakernel, hipFuncAttributeMaxDynamicSharedMemorySize, LDS_BYTES) != hipSuccess) { fprintf(stderr, "kernel_launch: hipFuncSetAttribute failed\n"); grid_blocks = -1; return; }
        if (hipOccupancyMaxActiveBlocksPerMultiprocessor(&per_cu, (const void*)fwd_megakernel, 512, LDS_BYTES) != hipSuccess || per_cu < 1) { fprintf(stderr, "kernel_launch: occupancy query failed (%d)\n", per_cu); per_cu = 1; (void)hipGetLastError(); }
        grid_blocks = cus * 1;
    }
    if (grid_blocks < 0) return;
    Params p{};
    const float** pp = (const float**)&p;
    for (int i = 0; i < 21; ++i) pp[i] = (const float*)d_in[i];
    p.out = (float*)d_out; p.ws = (unsigned char*)d_ws;
    void* args[] = {&p};
    hipError_t e = hipLaunchCooperativeKernel((const void*)fwd_megakernel, dim3(grid_blocks), dim3(512), args, LDS_BYTES, stream);
    if (e != hipSuccess) fprintf(stderr, "cooperative launch failed: %s (grid %d)\n", hipGetErrorString(e), grid_blocks);
}
```

```cpp
#include <hip/hip_runtime.h>
#include <hip/hip_cooperative_groups.h>
#include <cstdio>
namespace cg = cooperative_groups;

#define LAS __attribute__((address_space(3)))
typedef unsigned short bf16_t;
typedef short bf16x8 __attribute__((ext_vector_type(8)));
typedef float f32x4 __attribute__((ext_vector_type(4)));
typedef unsigned u32x4 __attribute__((ext_vector_type(4)));
typedef unsigned u32x2 __attribute__((ext_vector_type(2)));

constexpr int NB = 8, SEQ = 2048, CTXL = 256, NLAT = NB * SEQ, NCTX = NB * CTXL, NTOK = NLAT + NCTX;
constexpr int INW = 15392;
constexpr int PW = 14592;
constexpr int CQ = 0, CK = 1024, CZNA = 2048, CUF = 3072, CZF = 4096, CXBC = 5120, CZS = 7168, CGNA = 8192, CDT = 14336;
constexpr int CA1 = CQ, CA2 = CK, CA3 = CUF, CYF = CXBC, CYB = CXBC + 1024;

constexpr size_t OFF_WINT = 0;
constexpr size_t OFF_WVT  = OFF_WINT + (size_t)PW * 2048 * 2;
constexpr size_t OFF_WCAT = OFF_WVT + (size_t)1024 * 2048 * 2;
constexpr size_t OFF_WOUT = OFF_WCAT + (size_t)2048 * 3072 * 2;
constexpr size_t OFF_W2T  = OFF_WOUT + (size_t)2048 * 2048 * 2;
constexpr size_t OFF_P    = OFF_W2T + (size_t)2048 * 1024 * 2;
constexpr size_t OFF_VT   = OFF_P + (size_t)NTOK * PW * 2;
constexpr size_t OFF_R1   = OFF_VT + (size_t)1024 * NTOK * 2;
constexpr size_t OFF_XL   = OFF_R1 + (size_t)NTOK * 2048 * 2;
constexpr size_t OFF_R2   = OFF_XL + (size_t)NTOK * 2048 * 4;
constexpr size_t OFF_DL   = OFF_R2 + (size_t)NTOK * 2048 * 2;
constexpr size_t OFF_DC   = OFF_DL + (size_t)2048 * 4096 * 2;
constexpr size_t OFF_DTV  = OFF_DC + (size_t)256 * 512 * 2;
constexpr size_t OFF_DEC  = OFF_DTV + (size_t)NTOK * 32 * 4;
constexpr size_t OFF_MOD  = OFF_DEC + (size_t)NTOK * 32 * 4;
constexpr size_t WS_END   = OFF_MOD + (size_t)2 * 9 * 6144 * 4;
constexpr size_t TTCTX_OFF = (size_t)8 * 2048 * 2048 * 2;
constexpr int LDS_BYTES = 133120;

struct Params {
    const float *x, *c, *ctx, *c_ctx, *w_ada, *b_ada, *norm_w, *w_in, *rpb, *four_w, *conv_w, *conv_b, *dt_bias, *a_log, *ssd_d,
                *ssd_norm_w, *wb_na, *wb_four, *wb_ssd, *w_out, *final_norm_w;
    float* out; unsigned char* ws;
};

typedef const __attribute__((address_space(4))) Params* KP;
__device__ __forceinline__ float bf2f(unsigned v) { return __uint_as_float(v << 16); }
__device__ __forceinline__ float bflo(unsigned v) { return __uint_as_float(v << 16); }
__device__ __forceinline__ float bfhi(unsigned v) { return __uint_as_float(v & 0xffff0000u); }
__device__ __forceinline__ unsigned cvt_pk_bf16(float lo, float hi) { unsigned r; asm volatile("v_cvt_pk_bf16_f32 %0, %1, %2" : "=v"(r) : "v"(lo), "v"(hi)); return r; }
__device__ __forceinline__ float silu_f(float x) { return x / (1.f + __expf(-x)); }
__device__ __forceinline__ float sigm_f(float x) { return 1.f / (1.f + __expf(-x)); }
__device__ __forceinline__ int opaque_tid() { const int w = __builtin_amdgcn_readfirstlane((int)threadIdx.x >> 6);
    int t = w * 64 + (int)__builtin_amdgcn_mbcnt_hi(~0u, __builtin_amdgcn_mbcnt_lo(~0u, 0u)); asm volatile("" : "+v"(t)); return t; }
__device__ __forceinline__ KP fresh(KP p) { asm volatile("" : "+s"(p)); return p; }
__device__ __forceinline__ unsigned char* fresh_ws(KP p) { unsigned char* w = p->ws; asm volatile("" : "+s"(w)); return w; }
__device__ __forceinline__ float wave_sum(float v) {
#pragma unroll
    for (int o = 32; o >= 1; o >>= 1) v += __shfl_xor(v, o);
    return v;
}

constexpr int BM = 256, BK = 64, HALF = 128, HTB = HALF * BK * 2, NXCD = 8, WGM = 8;
__device__ __forceinline__ int lds_byte(int r, int c) { const int st = (r >> 4) * 2 + (c >> 5), rr = r & 15, cc = c & 31, ob = rr * 64 + cc * 2; return st * 1024 + (ob ^ (((ob >> 9) & 1) << 5)); }
__device__ __forceinline__ void stage_rc(int b, int& R, int& C) { const int st = b / 1024, sb = b % 1024, swz = sb ^ (((sb >> 9) & 1) << 5); R = (st >> 1) * 16 + swz / 64; C = (st & 1) * 32 + (swz % 64) / 2; }
__device__ __forceinline__ int perm32(int rho) { const int n = rho >> 4, i = rho & 15; return 8 * (i >> 2) + 4 * n + (i & 3); }

struct Unit { const char* a; const char* b; int pm, pn, z; };
struct GSched {
    const char* A; const char* B; unsigned a_tile, b_tile; int az_lin, az_x2, bz_lin; int nM, nN, nZ, G, c;
    __device__ __forceinline__ bool next(int i, Unit& u) const {
        const int ti = i / nZ, z = i - ti * nZ;
        const long L = (long)ti * G + c; const int nwg = nM * nN; if (L >= nwg) return false;
        int wgid = (int)L; { const int q = nwg / NXCD, r = nwg % NXCD, xcd = wgid % NXCD, off = wgid / NXCD; wgid = (xcd < r ? xcd * (q + 1) : r * (q + 1) + (xcd - r) * q) + off; }
        const int nig = WGM * nN, gid = wgid / nig, fm = gid * WGM, gsz = (nM - fm) < WGM ? (nM - fm) : WGM;
        u.pm = fm + ((wgid % nig) % gsz); u.pn = (wgid % nig) / gsz; u.z = z;
        u.a = A + (size_t)u.pm * a_tile + (size_t)(z * az_lin + (z == 2 ? az_x2 : 0));
        u.b = B + (size_t)u.pn * b_tile + (size_t)(z * bz_lin);
        return true;
    }
};
__device__ __forceinline__ GSched make_sched(const void* A, int lda, const void* B, int ldb, int nM, int nN) {
    GSched S; S.A = (const char*)A; S.B = (const char*)B; S.a_tile = (unsigned)(BM * lda * 2); S.b_tile = (unsigned)(BM * ldb * 2);
    S.az_lin = 0; S.az_x2 = 0; S.bz_lin = 0; S.nM = nM; S.nN = nN; S.nZ = 1; S.G = (int)gridDim.x; S.c = (int)blockIdx.x; return S;
}

struct InSched {
    const char* H; const char* W; const char* WV; int nctx, per, G, c;
    __device__ __forceinline__ bool next(int i, Unit& u) const {
        long L = (long)i * G + c;
        if (L < 3648) { const int nwg = 3648, nM = 64, nN = 57;
            int wgid = (int)L; { const int q = nwg / NXCD, r = nwg % NXCD, xcd = wgid % NXCD, off = wgid / NXCD; wgid = (xcd < r ? xcd * (q + 1) : r * (q + 1) + (xcd - r) * q) + off; }
            const int nig = WGM * nN, gid = wgid / nig, fm = gid * WGM, gsz = (nM - fm) < WGM ? (nM - fm) : WGM;
            u.pm = fm + ((wgid % nig) % gsz); u.pn = (wgid % nig) / gsz; u.z = 0;
            u.a = H + (size_t)u.pm * 1048576; u.b = W + (size_t)u.pn * 1048576; return true; }
        L -= 3648;
        if (L < nctx) { const int q = (int)L / per, j = (int)L % per; u.pm = 64 + q; u.pn = per == 57 ? j : (j < 4 ? 4 + j : (j < 12 ? 16 + j : 56)); u.z = 0;
            u.a = H + (size_t)u.pm * 1048576; u.b = W + (size_t)u.pn * 1048576; return true; }
        L -= nctx; if (L >= 288) return false;
        u.pm = (int)L & 3; u.pn = (int)L >> 2; u.z = 1; u.a = WV + (size_t)u.pm * 1048576; u.b = H + (size_t)u.pn * 1048576; return true;
    }
};

template <class Epi, class Sched>
__device__ __forceinline__ void gemm_phase(LAS unsigned char* lds, const int lda, const int ldb, const int K, const Sched& S, const Epi& E) {
    const int tid = opaque_tid(), wid = __builtin_amdgcn_readfirstlane(tid >> 6), lane = tid & 63, wr = wid >> 2, wc = wid & 3, fr = lane & 15, fq = lane >> 4;
    const int nt = K / BK;
    unsigned voffA[2], voffB[2];
#pragma unroll
    for (int i = 0; i < 2; ++i) { int R, C; stage_rc(tid * 16 + i * 8192, R, C); const int Rb = Epi::PERM ? ((R & ~31) + perm32(R & 31)) : R;
        voffA[i] = (unsigned)(R * lda + C) * 2u; voffB[i] = (unsigned)(Rb * ldb + C) * 2u; }
    const size_t kstep = (size_t)(BK * 2);
    const size_t hstepA = (size_t)HALF * lda * 2, hstepB = (size_t)HALF * ldb * 2;
    const unsigned ldsw = (unsigned)wid * 1024u;
    const int aoff = lds_byte(wr * 64 + fr, fq * 8), boff = lds_byte(wc * 32 + fr, fq * 8);
#define PG8_SA(b, h) (((b) * 2 + (h)) * HTB)
#define PG8_SB(b, h) ((4 + (b) * 2 + (h)) * HTB)
#define PG8_STAGE(bufoff, gbase, voff) do { _Pragma("unroll") for (int _i = 0; _i < 2; ++_i) \
        __builtin_amdgcn_global_load_lds((const unsigned*)((const char*)(gbase) + (voff)[_i]), (LAS unsigned*)(lds + (bufoff) + ldsw + _i * 8192), 16, 0, 0); } while (0)
#define PG8_LDA(dst, b, h) do { _Pragma("unroll") for (int m = 0; m < 4; ++m) _Pragma("unroll") for (int k = 0; k < 2; ++k) dst[m][k] = *(const LAS bf16x8*)(lds + PG8_SA(b, h) + aoff + m * 2048 + k * 1024); } while (0)
#define PG8_LDB(dst, b, h) do { _Pragma("unroll") for (int n = 0; n < 2; ++n) _Pragma("unroll") for (int k = 0; k < 2; ++k) dst[n][k] = *(const LAS bf16x8*)(lds + PG8_SB(b, h) + boff + n * 2048 + k * 1024); } while (0)
#define PG8_MMA(ai, bj, At, Bt) do { __builtin_amdgcn_s_setprio(1); _Pragma("unroll") for (int m = 0; m < 4; ++m) _Pragma("unroll") for (int n = 0; n < 2; ++n) _Pragma("unroll") for (int k = 0; k < 2; ++k) \
        acc[ai][bj][m][n] = __builtin_amdgcn_mfma_f32_16x16x32_bf16(Bt[n][k], At[m][k], acc[ai][bj][m][n], 0, 0, 0); __builtin_amdgcn_s_setprio(0); } while (0)
#define PG8_WAIT_V(n) asm volatile("s_waitcnt vmcnt(" #n ")" ::: "memory")
#define PG8_WAIT_L(n) asm volatile("s_waitcnt lgkmcnt(" #n ")" ::: "memory")
#define PG8_BAR __builtin_amdgcn_s_barrier()
#define PG8_SCHED __builtin_amdgcn_sched_barrier(0)
    Unit cur, nxt; int ui = 0;
    if (!S.next(0, cur)) return;
    f32x4 acc[2][2][4][2];
#pragma unroll
    for (int a = 0; a < 2; ++a)
#pragma unroll
        for (int b = 0; b < 2; ++b)
#pragma unroll
            for (int m = 0; m < 4; ++m)
#pragma unroll
                for (int n = 0; n < 2; ++n) acc[a][b][m][n] = (f32x4){0.f, 0.f, 0.f, 0.f};
    bf16x8 At[4][2], B0[2][2], B1[2][2];
    const char* cA = cur.a; const char* cB = cur.b;
    PG8_STAGE(PG8_SB(0, 0), cB, voffB); PG8_STAGE(PG8_SA(0, 0), cA, voffA); PG8_STAGE(PG8_SB(0, 1), cB + hstepB, voffB); PG8_STAGE(PG8_SA(0, 1), cA + hstepA, voffA);
    if (wr == 1) PG8_BAR;
    PG8_WAIT_V(4); PG8_BAR;
    PG8_STAGE(PG8_SB(1, 0), cB + kstep, voffB); PG8_STAGE(PG8_SA(1, 0), cA + kstep, voffA); PG8_STAGE(PG8_SB(1, 1), cB + hstepB + kstep, voffB);
    PG8_WAIT_V(6); PG8_BAR;
    for (;;) {
        const bool has_next = S.next(ui + 1, nxt);
        const char* nA = has_next ? nxt.a : cA; const char* nB = has_next ? nxt.b : cB;
        for (int t = 0; t < nt; t += 2) {
            const bool last = (t == nt - 2);
            const char* a1 = cA + (size_t)(t + 1) * kstep;
            const char* a2 = last ? nA : cA + (size_t)(t + 2) * kstep; const char* b2 = last ? nB : cB + (size_t)(t + 2) * kstep;
            const char* a3 = a2 + kstep; const char* b3 = b2 + kstep;
            PG8_LDB(B0, 0, 0); PG8_SCHED; PG8_LDA(At, 0, 0); PG8_STAGE(PG8_SA(1, 1), a1 + hstepA, voffA);
            PG8_WAIT_L(8); PG8_BAR; PG8_WAIT_L(0); PG8_MMA(0, 0, At, B0); PG8_BAR; PG8_SCHED;
            PG8_LDB(B1, 0, 1); PG8_STAGE(PG8_SB(0, 0), b2, voffB);
            PG8_BAR; PG8_WAIT_L(0); PG8_MMA(0, 1, At, B1); PG8_BAR;
            PG8_LDA(At, 0, 1); PG8_STAGE(PG8_SA(0, 0), a2, voffA);
            PG8_BAR; PG8_WAIT_L(0); PG8_MMA(1, 0, At, B0); PG8_BAR; PG8_SCHED;
            PG8_STAGE(PG8_SB(0, 1), b2 + hstepB, voffB);
            PG8_WAIT_V(6); PG8_BAR; PG8_MMA(1, 1, At, B1); PG8_BAR;
            PG8_LDB(B0, 1, 0); PG8_SCHED; PG8_LDA(At, 1, 0); PG8_STAGE(PG8_SA(0, 1), a2 + hstepA, voffA);
            PG8_WAIT_L(8); PG8_BAR; PG8_WAIT_L(0); PG8_MMA(0, 0, At, B0); PG8_BAR; PG8_SCHED;
            PG8_LDB(B1, 1, 1); PG8_STAGE(PG8_SB(1, 0), b3, voffB);
            PG8_BAR; PG8_WAIT_L(0); PG8_MMA(0, 1, At, B1); PG8_BAR;
            PG8_LDA(At, 1, 1); PG8_STAGE(PG8_SA(1, 0), a3, voffA);
            PG8_BAR; PG8_WAIT_L(0); PG8_MMA(1, 0, At, B0); PG8_BAR; PG8_SCHED;
            PG8_STAGE(PG8_SB(1, 1), b3 + hstepB, voffB);
            PG8_WAIT_V(6); PG8_BAR; PG8_MMA(1, 1, At, B1); PG8_BAR;
        }
        E(acc, cur, wr, wc, fr, fq);
        if (!has_next) break;
#pragma unroll
        for (int a = 0; a < 2; ++a)
#pragma unroll
            for (int b = 0; b < 2; ++b)
#pragma unroll
                for (int m = 0; m < 4; ++m)
#pragma unroll
                    for (int n = 0; n < 2; ++n) acc[a][b][m][n] = (f32x4){0.f, 0.f, 0.f, 0.f};
        cur = nxt; cA = nA; cB = nB; ++ui;
    }
    PG8_WAIT_V(0);
    if (wr == 0) PG8_BAR;
    PG8_BAR;
#undef PG8_SA
#undef PG8_SB
#undef PG8_STAGE
#undef PG8_LDA
#undef PG8_LDB
#undef PG8_MMA
#undef PG8_WAIT_V
#undef PG8_WAIT_L
#undef PG8_BAR
#undef PG8_SCHED
}

struct EpiStore {
    static constexpr bool PERM = true; bf16_t* O; size_t ldc;
    __device__ __forceinline__ void operator()(const f32x4 (&acc)[2][2][4][2], const Unit& u, int wr, int wc, int fr, int fq) const {
        const int row0 = u.pm * BM + wr * 64 + fr, col0 = u.pn * BM + wc * 32 + 8 * fq;
#pragma unroll
        for (int ai = 0; ai < 2; ++ai)
#pragma unroll
            for (int m = 0; m < 4; ++m) { bf16_t* rowp = O + (size_t)(row0 + ai * HALF + m * 16) * ldc + col0;
#pragma unroll
                for (int bj = 0; bj < 2; ++bj) { const f32x4 v0 = acc[ai][bj][m][0], v1 = acc[ai][bj][m][1];
                    u32x4 w; w.x = cvt_pk_bf16(v0[0], v0[1]); w.y = cvt_pk_bf16(v0[2], v0[3]); w.z = cvt_pk_bf16(v1[0], v1[1]); w.w = cvt_pk_bf16(v1[2], v1[3]);
                    *(u32x4*)(rowp + bj * HALF) = w; } }
    }
};
struct EpiIn {
    static constexpr bool PERM = true; bf16_t* Pm; bf16_t* VT;
    __device__ __forceinline__ void operator()(const f32x4 (&acc)[2][2][4][2], const Unit& u, int wr, int wc, int fr, int fq) const {
        const int row0 = u.pm * BM + wr * 64 + fr, col0 = u.pn * BM + wc * 32 + 8 * fq;
        bf16_t* O = u.z ? VT : Pm; const size_t ldc = u.z ? (size_t)NTOK : (size_t)PW;
#pragma unroll
        for (int ai = 0; ai < 2; ++ai)
#pragma unroll
            for (int m = 0; m < 4; ++m) { bf16_t* rowp = O + (size_t)(row0 + ai * HALF + m * 16) * ldc + col0;
#pragma unroll
                for (int bj = 0; bj < 2; ++bj) { const f32x4 v0 = acc[ai][bj][m][0], v1 = acc[ai][bj][m][1];
                    u32x4 w; w.x = cvt_pk_bf16(v0[0], v0[1]); w.y = cvt_pk_bf16(v0[2], v0[3]); w.z = cvt_pk_bf16(v1[0], v1[1]); w.w = cvt_pk_bf16(v1[2], v1[3]);
                    *(u32x4*)(rowp + bj * HALF) = w; } }
    }
};
struct EpiTT {
    static constexpr bool PERM = true; bf16_t* TTlat; bf16_t* TTctx;
    __device__ __forceinline__ void operator()(const f32x4 (&acc)[2][2][4][2], const Unit& u, int wr, int wc, int fr, int fq) const {
        const int row0 = u.pm * BM + wr * 64 + fr; const int cw = wc * 32 + 8 * fq;
        bf16_t* base; size_t L;
        if (u.pn < 64) { const int b = u.pn >> 3; L = 2048; base = TTlat + (size_t)b * 2048 * 2048 + (u.pn & 7) * 256 + cw; }
        else { const int b = u.pn - 64; L = 256; base = TTctx + (size_t)b * 2048 * 256 + cw; }
#pragma unroll
        for (int ai = 0; ai < 2; ++ai)
#pragma unroll
            for (int m = 0; m < 4; ++m) { bf16_t* rowp = base + (size_t)(row0 + ai * HALF + m * 16) * L;
#pragma unroll
                for (int bj = 0; bj < 2; ++bj) { const f32x4 v0 = acc[ai][bj][m][0], v1 = acc[ai][bj][m][1];
                    u32x4 w; w.x = cvt_pk_bf16(v0[0], v0[1]); w.y = cvt_pk_bf16(v0[2], v0[3]); w.z = cvt_pk_bf16(v1[0], v1[1]); w.w = cvt_pk_bf16(v1[2], v1[3]);
                    *(u32x4*)(rowp + bj * HALF) = w; } }
    }
};
struct EpiFb {
    static constexpr bool PERM = true; bf16_t* Pm; int tok0; int L;
    __device__ __forceinline__ void operator()(const f32x4 (&acc)[2][2][4][2], const Unit& u, int wr, int wc, int fr, int fq) const {
        const int b = u.pn >> 2, ch0 = (u.pn & 3) * 256 + wc * 32 + 8 * fq;
        const int row0 = u.pm * BM + wr * 64 + fr;
#pragma unroll
        for (int ai = 0; ai < 2; ++ai)
#pragma unroll
            for (int m = 0; m < 4; ++m) { asm volatile("" ::: "memory"); bf16_t* rowp = Pm + (size_t)(tok0 + b * L + row0 + ai * HALF + m * 16) * PW + ch0;
#pragma unroll
                for (int bj = 0; bj < 2; ++bj) { const f32x4 v0 = acc[ai][bj][m][0], v1 = acc[ai][bj][m][1];
                    const u32x4 z = *(const u32x4*)(rowp + CZF + bj * HALF);
                    u32x4 w; w.x = cvt_pk_bf16(v0[0] * silu_f(bflo(z.x)), v0[1] * silu_f(bfhi(z.x))); w.y = cvt_pk_bf16(v0[2] * silu_f(bflo(z.y)), v0[3] * silu_f(bfhi(z.y)));
                    w.z = cvt_pk_bf16(v1[0] * silu_f(bflo(z.z)), v1[1] * silu_f(bfhi(z.z))); w.w = cvt_pk_bf16(v1[2] * silu_f(bflo(z.w)), v1[3] * silu_f(bfhi(z.w)));
                    *(u32x4*)(rowp + CA2 + bj * HALF) = w; } }
    }
};
struct EpiMerge {
    static constexpr bool PERM = true; const bf16_t* Pm; float* scratch; bf16_t* M1;
    __device__ __forceinline__ void operator()(const f32x4 (&acc)[2][2][4][2], const Unit& u, int wr, int wc, int fr, int fq) const {
        const int row0 = u.pm * BM + wr * 64 + fr, col0 = u.pn * BM + wc * 32 + 8 * fq;
        float* sp = scratch + (size_t)blockIdx.x * 65536 + (size_t)opaque_tid() * 4;
        const bf16_t* gp = Pm + (size_t)row0 * PW + CGNA + u.z * 2048 + col0;
        bf16_t* mp = M1 + (size_t)row0 * 2048 + col0;
        const int z = u.z;
#pragma unroll
        for (int ai = 0; ai < 2; ++ai)
#pragma unroll
            for (int m = 0; m < 4; ++m)
#pragma unroll
                for (int bj = 0; bj < 2; ++bj)
#pragma unroll
                    for (int n = 0; n < 2; ++n) { asm volatile("" ::: "memory");
                        const int ro = ai * HALF + m * 16;
                        const f32x4 v = acc[ai][bj][m][n];
                        const u32x2 g = *(const u32x2*)(gp + (size_t)ro * PW + bj * HALF + n * 4);
                        asm volatile("" : "+v"(sp));
                        f32x4 t;
                        t[0] = v[0] * sigm_f(bflo(g.x)); t[1] = v[1] * sigm_f(bfhi(g.x)); t[2] = v[2] * sigm_f(bflo(g.y)); t[3] = v[3] * sigm_f(bfhi(g.y));
                        if (z > 0) t += *(const f32x4*)sp;
                        if (z < 2) *(f32x4*)sp = t;
                        else { u32x2 w; w.x = cvt_pk_bf16(t[0], t[1]); w.y = cvt_pk_bf16(t[2], t[3]); *(u32x2*)(mp + (size_t)ro * 2048 + bj * HALF + n * 4) = w; }
                        sp += 2048; }
    }
};
struct EpiOut {
    static constexpr bool PERM = false; const float* xlat; const float* xctx; float* xo; const float* mod;
    __device__ __forceinline__ void operator()(const f32x4 (&acc)[2][2][4][2], const Unit& u, int wr, int wc, int fr, int fq) const {
        const int row0 = u.pm * BM + wr * 64 + fr, col0 = u.pn * BM + wc * 32 + 4 * fq;
        const int vec = u.pm < 64 ? (u.pm >> 3) : 8;
        const float* src = u.pm < 64 ? xlat : (xctx - (size_t)NLAT * 2048);
        const float* gp = mod + (size_t)vec * 6144 + 4096 + col0;
        f32x4 gv[2][2];
#pragma unroll
        for (int bj = 0; bj < 2; ++bj)
#pragma unroll
            for (int n = 0; n < 2; ++n) gv[bj][n] = *(const f32x4*)(gp + bj * HALF + n * 16);
#pragma unroll
        for (int ai = 0; ai < 2; ++ai)
#pragma unroll
            for (int m = 0; m < 4; ++m) { asm volatile("" ::: "memory"); const size_t ro = (size_t)(row0 + ai * HALF + m * 16) * 2048 + col0;
#pragma unroll
                for (int bj = 0; bj < 2; ++bj)
#pragma unroll
                    for (int n = 0; n < 2; ++n) { const f32x4 xi = *(const f32x4*)(src + ro + bj * HALF + n * 16);
                        *(f32x4*)(xo + ro + bj * HALF + n * 16) = xi + gv[bj][n] * acc[ai][bj][m][n]; } }
    }
};

__device__ __forceinline__ void phase_ada(KP p, unsigned char* smem) {
    p = fresh(p);
    float* s = (float*)smem; float* red = s + 9 * 2048; float* mod = (float*)(fresh_ws(p) + OFF_MOD);
    const int tid = opaque_tid();
    for (int i = tid; i < 9 * 2048; i += 512) { const int v = i >> 11, k = i & 2047; const float cv = v < 8 ? p->c[v * 2048 + k] : p->c_ctx[k]; s[i] = silu_f(cv); }
    __syncthreads();
    for (int u = blockIdx.x; u < 192; u += gridDim.x) {
        const int l = u / 96, cgp = u % 96, cl = tid & 63, ks = tid >> 6;
        const float* w = p->w_ada + (size_t)l * 2048 * 6144 + cgp * 64 + cl;
        float a0 = 0, a1 = 0, a2 = 0, a3 = 0, a4 = 0, a5 = 0, a6 = 0, a7 = 0, a8 = 0;
#pragma unroll 4
        for (int k = ks * 256; k < ks * 256 + 256; ++k) { const float wv = w[(size_t)k * 6144];
            a0 += s[k] * wv; a1 += s[2048 + k] * wv; a2 += s[4096 + k] * wv; a3 += s[6144 + k] * wv; a4 += s[8192 + k] * wv;
            a5 += s[10240 + k] * wv; a6 += s[12288 + k] * wv; a7 += s[14336 + k] * wv; a8 += s[16384 + k] * wv; }
        float* rp = red + ks * 9 * 64 + cl;
        rp[0] = a0; rp[64] = a1; rp[128] = a2; rp[192] = a3; rp[256] = a4; rp[320] = a5; rp[384] = a6; rp[448] = a7; rp[512] = a8;
        __syncthreads();
        for (int i = tid; i < 9 * 64; i += 512) { float t = 0;
#pragma unroll
            for (int k2 = 0; k2 < 8; ++k2) t += red[k2 * 576 + i];
            const int v = i >> 6, col = cgp * 64 + (i & 63); mod[(size_t)(l * 9 + v) * 6144 + col] = t + p->b_ada[l * 6144 + col]; }
        __syncthreads();
    }
}

__device__ __forceinline__ void transpose_job(const float* src, int lds_, int c0, bf16_t* dst, int ldd, int r0, int k0, int ncols, int K, unsigned char* smem, int rot) {
    float* tile = (float*)smem;
    const int tid = opaque_tid(), ntn = (ncols + 127) >> 7, ntk = K >> 6, ntot = ntn * ntk, G = gridDim.x;
    const int kk = tid >> 5, nn = (tid & 31) * 4;
    f32x4 v[4];
    int t = (int)((blockIdx.x + G - (rot % G)) % G);
#define TJ_LOAD(tt) do { const int n0_ = ((tt) % ntn) * 128, kb_ = ((tt) / ntn) * 64; \
        _Pragma("unroll") for (int h_ = 0; h_ < 4; ++h_) { float zz_ = 0.f; asm volatile("" : "+v"(zz_)); v[h_] = (f32x4){zz_, zz_, zz_, zz_}; \
            if (n0_ + nn < ncols) v[h_] = *(const f32x4*)(src + (size_t)(kb_ + kk + 16 * h_) * lds_ + c0 + n0_ + nn); } } while (0)
    if (t < ntot) TJ_LOAD(t);
    while (t < ntot) {
        const int n0 = (t % ntn) * 128, kb = (t / ntn) * 64;
#pragma unroll
        for (int h = 0; h < 4; ++h) { float* tp = tile + (kk + 16 * h) * 129 + nn; tp[0] = v[h][0]; tp[1] = v[h][1]; tp[2] = v[h][2]; tp[3] = v[h][3]; }
        const int tn = t + G;
        if (tn < ntot) TJ_LOAD(tn);
        __syncthreads();
        { const int n = tid >> 2, kq = (tid & 3) * 16;
          if (n0 + n < ncols) {
#pragma unroll
              for (int hh = 0; hh < 2; ++hh) { const float* tp = tile + (kq + hh * 8) * 129 + n; u32x4 w;
                  w.x = cvt_pk_bf16(tp[0], tp[129]); w.y = cvt_pk_bf16(tp[2 * 129], tp[3 * 129]); w.z = cvt_pk_bf16(tp[4 * 129], tp[5 * 129]); w.w = cvt_pk_bf16(tp[6 * 129], tp[7 * 129]);
                  *(u32x4*)(dst + (size_t)(r0 + n0 + n) * ldd + k0 + kb + kq + hh * 8) = w; } } }
        __syncthreads();
        t = tn;
    }
#undef TJ_LOAD
}

__device__ __forceinline__ void phase_wprep(KP p, int l, unsigned char* smem) {
    p = fresh(p); unsigned char* wsl = fresh_ws(p);
    bf16_t* WinT = (bf16_t*)(wsl + OFF_WINT); bf16_t* WvT = (bf16_t*)(wsl + OFF_WVT); bf16_t* Wcat = (bf16_t*)(wsl + OFF_WCAT);
    bf16_t* Wout = (bf16_t*)(wsl + OFF_WOUT); bf16_t* W2T = (bf16_t*)(wsl + OFF_W2T);
    const float* win = p->w_in + (size_t)l * 2048 * INW;
    for (int jb = 0; jb < 9; ++jb) {
        const float* s_ = win; int ld_ = INW, c0 = 0, ldd = 2048, r0 = 0, k0 = 0, nc = 2048, K = 2048, rot = 0; bf16_t* d_ = WinT;
        switch (jb) {
            case 0: break;
            case 1: c0 = 3072; r0 = 2048; nc = 6144; break;
            case 2: c0 = 9248; r0 = 8192; nc = 6144; break;
            case 3: c0 = 9216; r0 = CDT; nc = 32; break;
            case 4: c0 = 2048; d_ = WvT; nc = 1024; rot = 32; break;
            case 5: s_ = p->wb_na + (size_t)l * 1024 * 2048; ld_ = 2048; d_ = Wcat; ldd = 3072; K = 1024; rot = 64; break;
            case 6: s_ = p->wb_four + (size_t)l * 1024 * 2048; ld_ = 2048; d_ = Wcat; ldd = 3072; k0 = 1024; K = 1024; rot = 64; break;
            case 7: s_ = p->wb_ssd + (size_t)l * 1024 * 2048; ld_ = 2048; d_ = Wcat; ldd = 3072; k0 = 2048; K = 1024; rot = 64; break;
            default: s_ = p->w_out + (size_t)l * 2048 * 2048; ld_ = 2048; d_ = Wout; break;
        }
        transpose_job(s_, ld_, c0, d_, ldd, r0, k0, nc, K, smem, rot);
    }
    { const size_t n16 = (size_t)(PW - CDT - 32) * 2048 * 2 / 16; u32x4* z = (u32x4*)(WinT + (size_t)(CDT + 32) * 2048);
      unsigned zz = 0u; asm volatile("" : "+v"(zz));
      for (size_t i = (size_t)blockIdx.x * 512 + opaque_tid(); i < n16; i += (size_t)gridDim.x * 512) z[i] = (u32x4){zz, zz, zz, zz}; }
    { float* ct = (float*)smem; float* st = ct + 256; const int tid = opaque_tid();
      __syncthreads();
      if (tid < 256) { ct[tid] = cospif((float)tid * (1.f / 128.f)); st[tid] = sinpif((float)tid * (1.f / 128.f)); }
      __syncthreads();
      const float* fw = p->four_w + (size_t)l * 1024 * 1024;
      for (int u = blockIdx.x; u < 256; u += gridDim.x) {
          const int i0 = (u >> 1) * 8, j = (u & 1) * 512 + tid, g = i0 >> 8, c0 = i0 & 255;
          float ac[8], as[8];
#pragma unroll
          for (int e = 0; e < 8; ++e) { ac[e] = 0.f; as[e] = 0.f; }
          for (int k2 = 0; k2 < 256; ++k2) { const float w = fw[(size_t)(g * 256 + k2) * 1024 + j];
#pragma unroll
              for (int e = 0; e < 8; ++e) { const int idx = (k2 * (c0 + e)) & 255; ac[e] += ct[idx] * w; as[e] += st[idx] * w; } }
          u32x4 wc, wsn;
          wc.x = cvt_pk_bf16(ac[0], ac[1]); wc.y = cvt_pk_bf16(ac[2], ac[3]); wc.z = cvt_pk_bf16(ac[4], ac[5]); wc.w = cvt_pk_bf16(ac[6], ac[7]);
          wsn.x = cvt_pk_bf16(as[0], as[1]); wsn.y = cvt_pk_bf16(as[2], as[3]); wsn.z = cvt_pk_bf16(as[4], as[5]); wsn.w = cvt_pk_bf16(as[6], as[7]);
          *(u32x4*)(W2T + (size_t)(j * 2 + 0) * 1024 + i0) = wc; *(u32x4*)(W2T + (size_t)(j * 2 + 1) * 1024 + i0) = wsn; }
      __syncthreads(); }
}

__device__ __forceinline__ void phase_dft(KP p) {
    unsigned char* wsl = fresh_ws(p);
    bf16_t* DL = (bf16_t*)(wsl + OFF_DL); bf16_t* DC = (bf16_t*)(wsl + OFF_DC);
    const size_t gtid = (size_t)blockIdx.x * 512 + opaque_tid(), gstr = (size_t)gridDim.x * 512;
    { const float sc = 0.001381067932f;
      for (size_t it = gtid; it < (size_t)2048 * 4096 / 8; it += gstr) { const int lp = (int)(it >> 9), rem = (int)(it & 511), cs = rem >> 8, l0 = (rem & 255) * 8;
          float v[8];
#pragma unroll
          for (int e = 0; e < 8; ++e) { const int m = (lp * (l0 + e)) & 2047; const float x = (float)m * (1.f / 1024.f); v[e] = cs ? -sc * sinpif(x) : sc * cospif(x); }
          u32x4 w; w.x = cvt_pk_bf16(v[0], v[1]); w.y = cvt_pk_bf16(v[2], v[3]); w.z = cvt_pk_bf16(v[4], v[5]); w.w = cvt_pk_bf16(v[6], v[7]);
          *(u32x4*)(DL + (size_t)lp * 4096 + cs * 2048 + l0) = w; } }
    { const float sc = 0.00390625f;
      for (size_t it = gtid; it < (size_t)256 * 512 / 8; it += gstr) { const int lp = (int)(it >> 6), rem = (int)(it & 63), cs = rem >> 5, l0 = (rem & 31) * 8;
          float v[8];
#pragma unroll
          for (int e = 0; e < 8; ++e) { const int m = (lp * (l0 + e)) & 255; const float x = (float)m * (1.f / 128.f); v[e] = cs ? -sc * sinpif(x) : sc * cospif(x); }
          u32x4 w; w.x = cvt_pk_bf16(v[0], v[1]); w.y = cvt_pk_bf16(v[2], v[3]); w.z = cvt_pk_bf16(v[4], v[5]); w.w = cvt_pk_bf16(v[6], v[7]);
          *(u32x4*)(DC + (size_t)lp * 512 + cs * 256 + l0) = w; } }
}

__device__ __forceinline__ void phase_norm(KP p, int mode) {
    p = fresh(p); unsigned char* wsl = fresh_ws(p); const int tid = opaque_tid();
    const int lane = tid & 63, wv = tid >> 6;
    const float* xl = (const float*)(wsl + OFF_XL); bf16_t* h = (bf16_t*)(wsl + OFF_R1); const float* mod = (const float*)(wsl + OFF_MOD);
    const int ntok = mode == 2 ? NLAT : NTOK;
    for (int tok = blockIdx.x * 8 + wv; tok < ntok; tok += gridDim.x * 8) {
        const float* src = mode == 0 ? (tok < NLAT ? p->x + (size_t)tok * 2048 : p->ctx + (size_t)(tok - NLAT) * 2048) : xl + (size_t)tok * 2048;
        f32x4 v[8]; float ss = 0.f;
#pragma unroll
        for (int i = 0; i < 8; ++i) { v[i] = *(const f32x4*)(src + (i * 64 + lane) * 4); ss += v[i][0] * v[i][0] + v[i][1] * v[i][1] + v[i][2] * v[i][2] + v[i][3] * v[i][3]; }
        ss = wave_sum(ss);
        const float rstd = rsqrtf(ss * (1.f / 2048.f) + 1e-6f);
        if (mode == 2) {
#pragma unroll
            for (int i = 0; i < 8; ++i) { const int c = (i * 64 + lane) * 4; const f32x4 w = *(const f32x4*)(p->final_norm_w + c); *(f32x4*)(p->out + (size_t)tok * 2048 + c) = v[i] * rstd * w; }
        } else {
            const int vec = tok < NLAT ? (tok >> 11) : 8; const float* mp = mod + (size_t)(mode * 9 + vec) * 6144; const float* nw = p->norm_w + mode * 2048;
#pragma unroll
            for (int i = 0; i < 8; ++i) { const int c = (i * 64 + lane) * 4; const f32x4 w = *(const f32x4*)(nw + c), sh = *(const f32x4*)(mp + c), sc = *(const f32x4*)(mp + 2048 + c);
                const f32x4 o = (v[i] * rstd * w) * (sc + 1.f) + sh;
                u32x2 pk; pk.x = cvt_pk_bf16(o[0], o[1]); pk.y = cvt_pk_bf16(o[2], o[3]); *(u32x2*)(h + (size_t)tok * 2048 + c) = pk; }
        }
    }
}

__device__ __forceinline__ void phase_conv(KP p, int layer, unsigned char* smem) {
    float2* tab = (float2*)smem;
    p = fresh(p); unsigned char* wsl = fresh_ws(p);
    const int tid = opaque_tid();
    __syncthreads();
    for (int i = tid; i < 2048; i += 512) { const int pos = i >> 5, jj = i & 31; const float inv = exp2f(-(float)jj * (13.287712379549449f / 32.f)); const float ang = (float)pos * inv; tab[i] = make_float2(__cosf(ang), __sinf(ang)); }
    __syncthreads();
    const bf16_t* Pm = (const bf16_t*)(wsl + OFF_P); bf16_t* U = (bf16_t*)(wsl + OFF_R1);
    float* dtv = (float*)(wsl + OFF_DTV); float* dec = (float*)(wsl + OFF_DEC);
    const int ch = tid * 4;
    float w[7][4], bias[4];
#pragma unroll
    for (int j = 0; j < 7; ++j) { const f32x4 t = *(const f32x4*)(p->conv_w + ((size_t)layer * 7 + j) * 2048 + ch); w[j][0] = t[0]; w[j][1] = t[1]; w[j][2] = t[2]; w[j][3] = t[3]; }
    { const f32x4 t = *(const f32x4*)(p->conv_b + (size_t)layer * 2048 + ch); bias[0] = t[0]; bias[1] = t[1]; bias[2] = t[2]; bias[3] = t[3]; }
    const bool ropech = ch >= 1024; const int n = (ch - 1024) & 127, half = n >> 6, i64 = n & 63, jj0 = i64 & 31; const bool first = i64 < 32;
    for (int u = blockIdx.x; u < 1152; u += gridDim.x) {
        int tokbase, s0, L; bool lat;
        if (u < 1024) { tokbase = (u >> 7) * 2048; s0 = (u & 127) * 16; L = 2048; lat = true; } else { const int v = u - 1024; tokbase = NLAT + (v >> 4) * 256; s0 = (v & 15) * 16; L = 256; lat = false; }
        float xr[22][4];
#pragma unroll
        for (int i = 0; i < 22; ++i) { const int s = s0 - 3 + i; u32x2 t = {0u, 0u}; if (s >= 0 && s < L) t = *(const u32x2*)(Pm + (size_t)(tokbase + s) * PW + CXBC + ch);
            xr[i][0] = bflo(t.x); xr[i][1] = bfhi(t.x); xr[i][2] = bflo(t.y); xr[i][3] = bfhi(t.y); }
#pragma unroll
        for (int t = 0; t < 16; ++t) { float o[4];
#pragma unroll
            for (int k = 0; k < 4; ++k) { float a = bias[k];
#pragma unroll
                for (int j = 0; j < 7; ++j) a += w[j][k] * xr[t + j][k];
                o[k] = silu_f(a); }
            const int l = s0 + t; const int pos = half ? (l & 63) : (l >> 6);
#pragma unroll
            for (int k = 0; k < 4; ++k) { const float pv = __shfl_xor(o[k], 8);
                if (lat && ropech) { const float2 cs = tab[pos * 32 + jj0 + k]; o[k] = first ? (o[k] * cs.x - pv * cs.y) : (pv * cs.y + o[k] * cs.x); } }
            u32x2 pk; pk.x = cvt_pk_bf16(o[0], o[1]); pk.y = cvt_pk_bf16(o[2], o[3]);
            *(u32x2*)(U + (size_t)(tokbase + l) * 2048 + ch) = pk; }
        { const int t = tid >> 5, dh = tid & 31; const size_t tok = (size_t)(tokbase + s0 + t);
          const float raw = bf2f(Pm[tok * PW + CDT + dh]) + p->dt_bias[layer * 32 + dh];
          const float ex = __expf(raw); const float dt = raw > 15.f ? raw : (ex < 0.02f ? ex * (1.f - ex * (0.5f - ex * (1.f / 3.f))) : __logf(1.f + ex)); const float a = -__expf(p->a_log[layer * 32 + dh]);
          dtv[tok * 32 + dh] = dt; dec[tok * 32 + dh] = dt * a; }
    }
    __syncthreads();
}

constexpr int ATT_VT_OFF = 65536, ATT_VT_ROW = 528;
template <bool WIN>
__device__ __forceinline__ void attn_unit(KP p, unsigned char* wsl, LAS unsigned char* lds, int tid, int layer, int b, int h, int r, int j, int qtok0) {
    asm volatile("" : "+v"(tid));
    const int lane = tid & 63, c16 = lane & 15, q4 = lane >> 4;
    bf16_t* Pm = (bf16_t*)(wsl + OFF_P); const bf16_t* VT = (const bf16_t*)(wsl + OFF_VT);
    bf16x8 qf[4];
    { const bf16_t* qp = Pm + (size_t)(qtok0 + c16) * PW + CQ + h * 128 + q4 * 8;
#pragma unroll
      for (int kk = 0; kk < 4; ++kk) qf[kk] = *(const bf16x8*)(qp + kk * 32); }
    const int start = WIN ? min(max(r - 4, 0), 24) : 0;
    const int kstart = WIN ? min(max(j * 16 - 8, 0), 32) : 0;
    const int kc0 = NLAT + b * 256, kw0 = b * 2048 + start * 64 + kstart;
    const float scale = 0.08838834764831845f;
    f32x4 s[16];
    unsigned pkA[16][2]; float mA = -3.0e38f, sumA = 0.f;
#pragma unroll
    for (int t = 0; t < 16; ++t) {
        f32x4 a = {0.f, 0.f, 0.f, 0.f};
        if (WIN) {
#pragma unroll
            for (int kk = 0; kk < 4; ++kk) a = __builtin_amdgcn_mfma_f32_16x16x32_bf16(*(const LAS bf16x8*)(lds + (t * 16 + c16) * 256 + (((kk * 4 + q4) ^ c16) * 16)), qf[kk], a, 0, 0, 0);
        } else {
            const bf16_t* kp = Pm + (size_t)(kc0 + t * 16 + c16) * PW + CK + h * 128 + q4 * 8;
#pragma unroll
            for (int kk = 0; kk < 4; ++kk) a = __builtin_amdgcn_mfma_f32_16x16x32_bf16(*(const bf16x8*)(kp + kk * 32), qf[kk], a, 0, 0, 0);
        }
#pragma unroll
        for (int i = 0; i < 4; ++i) { a[i] *= scale; mA = fmaxf(mA, a[i]); }
        s[t] = a;
    }
    mA = fmaxf(mA, __shfl_xor(mA, 16)); mA = fmaxf(mA, __shfl_xor(mA, 32));
#pragma unroll
    for (int t = 0; t < 16; ++t) { const float e0 = __expf(s[t][0] - mA), e1 = __expf(s[t][1] - mA), e2 = __expf(s[t][2] - mA), e3 = __expf(s[t][3] - mA);
        sumA += (e0 + e1) + (e2 + e3); pkA[t][0] = cvt_pk_bf16(e0, e1); pkA[t][1] = cvt_pk_bf16(e2, e3); }
    unsigned pkB[WIN ? 16 : 1][2]; float mB = -3.0e38f, sumB = 0.f;
    if (WIN) {
        const int qcol = j * 16 + c16, qstart = min(max(qcol - 8, 0), 48);
#pragma unroll
        for (int t = 0; t < 16; ++t) {
            const int kr = t >> 1, ct = t & 1;
            const bf16_t* kp = Pm + (size_t)(kw0 + kr * 64 + ct * 16 + c16) * PW + CK + h * 128 + q4 * 8;
            f32x4 a = {0.f, 0.f, 0.f, 0.f};
#pragma unroll
            for (int kk = 0; kk < 4; ++kk) a = __builtin_amdgcn_mfma_f32_16x16x32_bf16(*(const bf16x8*)(kp + kk * 32), qf[kk], a, 0, 0, 0);
            const int dr = start + kr - r + 7;
            const float* bp = p->rpb + ((size_t)(layer * 8 + h) * 15 + dr) * 31;
#pragma unroll
            for (int i = 0; i < 4; ++i) { const int kcol = kstart + ct * 16 + q4 * 4 + i; const bool valid = kcol >= qstart && kcol < qstart + 16;
                float v = -1e30f; if (valid) v = a[i] * scale + bp[kcol - qcol + 15];
                a[i] = v; mB = fmaxf(mB, v); }
            s[t] = a;
        }
        mB = fmaxf(mB, __shfl_xor(mB, 16)); mB = fmaxf(mB, __shfl_xor(mB, 32));
#pragma unroll
        for (int t = 0; t < 16; ++t) { const float e0 = __expf(s[t][0] - mB), e1 = __expf(s[t][1] - mB), e2 = __expf(s[t][2] - mB), e3 = __expf(s[t][3] - mB);
            sumB += (e0 + e1) + (e2 + e3); pkB[t][0] = cvt_pk_bf16(e0, e1); pkB[t][1] = cvt_pk_bf16(e2, e3); }
    }
    const float m = WIN ? fmaxf(mA, mB) : mA;
    const float fA = WIN ? __expf(mA - m) : 1.f, fB = WIN ? __expf(mB - m) : 0.f;
    float sum = sumA * fA + sumB * fB;
    sum += __shfl_xor(sum, 16); sum += __shfl_xor(sum, 32);
    const float inv = 1.f / sum, gA = fA * inv, gB = fB * inv;
    bf16_t* orow = Pm + (size_t)(qtok0 + c16) * PW + h * 128 + q4 * 4;
#pragma unroll
    for (int dt = 0; dt < 8; ++dt) {
        const bf16_t* vp = VT + (size_t)(h * 128 + dt * 16 + c16) * NTOK + q4 * 4;
        f32x4 oA = {0.f, 0.f, 0.f, 0.f}, oB = {0.f, 0.f, 0.f, 0.f};
#pragma unroll
        for (int u = 0; u < 8; ++u) {
            u32x2 va, vb;
            if (WIN) { const LAS unsigned char* vl = lds + ATT_VT_OFF + (dt * 16 + c16) * ATT_VT_ROW + ((2 * u) * 16 + q4 * 4) * 2; va = *(const LAS u32x2*)vl; vb = *(const LAS u32x2*)(vl + 32); }
            else { va = *(const u32x2*)(vp + kc0 + (2 * u) * 16); vb = *(const u32x2*)(vp + kc0 + (2 * u + 1) * 16); }
            const u32x4 vv = {va.x, va.y, vb.x, vb.y}; const u32x4 pp = {pkA[2 * u][0], pkA[2 * u][1], pkA[2 * u + 1][0], pkA[2 * u + 1][1]};
            oA = __builtin_amdgcn_mfma_f32_16x16x32_bf16(__builtin_bit_cast(bf16x8, vv), __builtin_bit_cast(bf16x8, pp), oA, 0, 0, 0); }
        if (WIN) {
#pragma unroll
            for (int u = 0; u < 8; ++u) {
                const u32x2 va = *(const u32x2*)(vp + kw0 + u * 64), vb = *(const u32x2*)(vp + kw0 + u * 64 + 16);
                const u32x4 vv = {va.x, va.y, vb.x, vb.y}; const u32x4 pp = {pkB[WIN ? 2 * u : 0][0], pkB[WIN ? 2 * u : 0][1], pkB[WIN ? 2 * u + 1 : 0][0], pkB[WIN ? 2 * u + 1 : 0][1]};
                oB = __builtin_amdgcn_mfma_f32_16x16x32_bf16(__builtin_bit_cast(bf16x8, vv), __builtin_bit_cast(bf16x8, pp), oB, 0, 0, 0); }
        }
        const u32x2 z = *(const u32x2*)(orow + CZNA + dt * 16);
        const float o0 = oA[0] * gA + oB[0] * gB, o1 = oA[1] * gA + oB[1] * gB, o2 = oA[2] * gA + oB[2] * gB, o3 = oA[3] * gA + oB[3] * gB;
        u32x2 w; w.x = cvt_pk_bf16(o0 * silu_f(bflo(z.x)), o1 * silu_f(bfhi(z.x))); w.y = cvt_pk_bf16(o2 * silu_f(bflo(z.y)), o3 * silu_f(bfhi(z.y)));
        *(u32x2*)(orow + CA1 + dt * 16) = w;
    }
}

__device__ __forceinline__ void phase_attn(KP p, int layer, unsigned char* smem) {
    p = fresh(p); unsigned char* wsl = fresh_ws(p); const int tid = opaque_tid();
    LAS unsigned char* lds = (LAS unsigned char*)smem;
    const int wv = __builtin_amdgcn_readfirstlane(tid >> 6);
    const bf16_t* Pm = (const bf16_t*)(wsl + OFF_P); const bf16_t* VT = (const bf16_t*)(wsl + OFF_VT);
    for (int bu = blockIdx.x; bu < 256; bu += gridDim.x) { const int b = bu >> 5, h = (bu >> 2) & 7, rg = bu & 3, kc0 = NLAT + b * 256;
        __syncthreads();
        int ts = tid; asm volatile("" : "+v"(ts));
#pragma unroll
        for (int k = 0; k < 8; ++k) { const int idx = ts + 512 * k;
            { const int key = idx >> 4, ch = idx & 15; *(LAS u32x4*)(lds + key * 256 + ((ch ^ (key & 15)) * 16)) = *(const u32x4*)(Pm + (size_t)(kc0 + key) * PW + CK + h * 128 + ch * 8); }
            { const int d = idx >> 5, pc = idx & 31; *(LAS u32x4*)(lds + ATT_VT_OFF + d * ATT_VT_ROW + pc * 16) = *(const u32x4*)(VT + (size_t)(h * 128 + d) * NTOK + kc0 + pc * 8); } }
        __syncthreads();
        const int r = rg * 8 + wv;
        for (int j = 0; j < 4; ++j) attn_unit<true>(p, wsl, lds, tid, layer, b, h, r, j, b * 2048 + r * 64 + j * 16);
    }
    if (layer == 0)
        for (int bu = blockIdx.x; bu < 128; bu += gridDim.x) { const int wu = bu * 8 + wv; const int qb = wu & 15, h = (wu >> 4) & 7, b = wu >> 7;
            attn_unit<false>(p, wsl, lds, tid, layer, b, h, 0, 0, NLAT + b * 256 + qb * 16); }
    __syncthreads();
}

__device__ __forceinline__ int scan_tok(int b, int dir, int s) {
    if (s < 256) return NLAT + b * 256 + (dir ? 255 - s : s);
    const int ss = s - 256; return b * 2048 + (dir ? 2047 - ss : ss);
}
__device__ __forceinline__ void phase_scan(KP p, unsigned char* smem) {
    constexpr int O_C = 0, O_B = 17408, O_BT = 34816, O_XT = 53248, O_H = 62464, O_CS = 97280, O_DT = 97536;
    const int tid = opaque_tid(); unsigned char* wsl = fresh_ws(p);
    LAS unsigned char* lds = (LAS unsigned char*)smem;
    const bf16_t* U = (const bf16_t*)(wsl + OFF_R1); bf16_t* Pm = (bf16_t*)(wsl + OFF_P);
    const float* dtv = (const float*)(wsl + OFF_DTV); const float* dag = (const float*)(wsl + OFF_DEC);
    const int lane = tid & 63, w = tid >> 6, c16 = lane & 15, q4 = lane >> 4;
    const int it = w >> 1, ptb = (w & 1) * 2;
    for (int u = blockIdx.x; u < 256; u += gridDim.x) {
        const int b = u >> 5, dir = (u >> 4) & 1, head = u & 15, g = head >> 2, dh = dir * 16 + head;
        const int ycol = (dir ? CYB : CYF) + head * 64;
        f32x4 hacc[4];
#pragma unroll
        for (int e = 0; e < 4; ++e) hacc[e] = (f32x4){0.f, 0.f, 0.f, 0.f};
        __syncthreads();
        for (int i = tid; i < 64 * 136 * 2 / 16; i += 512) *(LAS u32x4*)(lds + O_H + i * 16) = (u32x4){0u, 0u, 0u, 0u};
        u32x4 rc[2], rb[2], rx; float rdt = 0.f, rda = 0.f;
#define SCAN_LOAD(chunk) do { const int s0_ = (chunk) * 64; \
            _Pragma("unroll") for (int k_ = 0; k_ < 2; ++k_) { const int id_ = tid + 512 * k_; const size_t tk_ = (size_t)scan_tok(b, dir, s0_ + (id_ >> 4)); \
                rc[k_] = *(const u32x4*)(U + tk_ * 2048 + 1536 + g * 128 + (id_ & 15) * 8); rb[k_] = *(const u32x4*)(U + tk_ * 2048 + 1024 + g * 128 + (id_ & 15) * 8); } \
            { const size_t tk_ = (size_t)scan_tok(b, dir, s0_ + (tid >> 3)); rx = *(const u32x4*)(U + tk_ * 2048 + head * 64 + (tid & 7) * 8); } \
            if (tid < 64) { const size_t tk_ = (size_t)scan_tok(b, dir, s0_ + tid); rdt = dtv[tk_ * 32 + dh]; rda = dag[tk_ * 32 + dh]; } } while (0)
#define SCAN_STORE() do { \
            _Pragma("unroll") for (int k_ = 0; k_ < 2; ++k_) { const int id_ = tid + 512 * k_, row_ = id_ >> 4, pc_ = id_ & 15; \
                *(LAS u32x4*)(lds + O_C + (row_ * 136 + pc_ * 8) * 2) = rc[k_]; *(LAS u32x4*)(lds + O_B + (row_ * 136 + pc_ * 8) * 2) = rb[k_]; \
                const unsigned bw_[4] = {rb[k_].x, rb[k_].y, rb[k_].z, rb[k_].w}; \
                _Pragma("unroll") for (int e_ = 0; e_ < 4; ++e_) { *(LAS bf16_t*)(lds + O_BT + ((pc_ * 8 + 2 * e_) * 72 + row_) * 2) = (bf16_t)(bw_[e_] & 0xffffu); \
                                                                  *(LAS bf16_t*)(lds + O_BT + ((pc_ * 8 + 2 * e_ + 1) * 72 + row_) * 2) = (bf16_t)(bw_[e_] >> 16); } } \
            { const int row_ = tid >> 3, pc_ = tid & 7; const unsigned xw_[4] = {rx.x, rx.y, rx.z, rx.w}; \
              _Pragma("unroll") for (int e_ = 0; e_ < 4; ++e_) { *(LAS bf16_t*)(lds + O_XT + ((pc_ * 8 + 2 * e_) * 72 + row_) * 2) = (bf16_t)(xw_[e_] & 0xffffu); \
                                                                *(LAS bf16_t*)(lds + O_XT + ((pc_ * 8 + 2 * e_ + 1) * 72 + row_) * 2) = (bf16_t)(xw_[e_] >> 16); } } \
            if (tid < 64) { float v_ = rda; \
                _Pragma("unroll") for (int o_ = 1; o_ < 64; o_ <<= 1) { const float t_ = __shfl_up(v_, o_); if (lane >= o_) v_ += t_; } \
                *(LAS float*)(lds + O_CS + tid * 4) = v_; *(LAS float*)(lds + O_DT + tid * 4) = rdt; } } while (0)
        SCAN_LOAD(0);
        SCAN_STORE();
        __syncthreads();
        for (int c = 0; c < 36; ++c) {
            const int cur = c & 1;
            if (c + 1 < 36) SCAN_LOAD(c + 1);
            const LAS unsigned char* Hc = lds + O_H + cur * 17408;
            LAS unsigned char* Hn = lds + O_H + (cur ^ 1) * 17408;
            const int irow = it * 16 + c16;
            const float cs_i = *(const LAS float*)(lds + O_CS + irow * 4);
            const float cs_last = *(const LAS float*)(lds + O_CS + 63 * 4);
            bf16x8 xf[4][2];
#pragma unroll
            for (int pt = 0; pt < 4; ++pt)
#pragma unroll
                for (int uu = 0; uu < 2; ++uu) { const LAS unsigned char* xp = lds + O_XT + ((pt * 16 + c16) * 72 + uu * 32 + q4 * 4) * 2;
                    const u32x2 va = *(const LAS u32x2*)xp, vb = *(const LAS u32x2*)(xp + 32); const u32x4 vv = {va.x, va.y, vb.x, vb.y}; xf[pt][uu] = __builtin_bit_cast(bf16x8, vv); }
            bf16x8 cf[4];
#pragma unroll
            for (int kk = 0; kk < 4; ++kk) cf[kk] = *(const LAS bf16x8*)(lds + O_C + (irow * 136 + kk * 32 + q4 * 8) * 2);
            f32x4 yacc[2];
#pragma unroll
            for (int e = 0; e < 2; ++e) { f32x4 a = {0.f, 0.f, 0.f, 0.f};
#pragma unroll
                for (int kk = 0; kk < 4; ++kk) a = __builtin_amdgcn_mfma_f32_16x16x32_bf16(*(const LAS bf16x8*)(Hc + (((ptb + e) * 16 + c16) * 136 + kk * 32 + q4 * 8) * 2), cf[kk], a, 0, 0, 0);
                yacc[e] = a * __expf(cs_i); }
            unsigned pk[4][2];
#pragma unroll
            for (int jt = 0; jt < 4; ++jt) { pk[jt][0] = 0u; pk[jt][1] = 0u;
                if (jt <= it) { f32x4 a = {0.f, 0.f, 0.f, 0.f};
#pragma unroll
                    for (int kk = 0; kk < 4; ++kk) a = __builtin_amdgcn_mfma_f32_16x16x32_bf16(*(const LAS bf16x8*)(lds + O_B + ((jt * 16 + c16) * 136 + kk * 32 + q4 * 8) * 2), cf[kk], a, 0, 0, 0);
                    const f32x4 csj = *(const LAS f32x4*)(lds + O_CS + (jt * 16 + q4 * 4) * 4), dtj = *(const LAS f32x4*)(lds + O_DT + (jt * 16 + q4 * 4) * 4);
                    float m[4];
#pragma unroll
                    for (int r = 0; r < 4; ++r) { const int j = jt * 16 + q4 * 4 + r; m[r] = (j <= irow) ? a[r] * __expf(cs_i - csj[r]) * dtj[r] : 0.f; }
                    pk[jt][0] = cvt_pk_bf16(m[0], m[1]); pk[jt][1] = cvt_pk_bf16(m[2], m[3]); } }
#pragma unroll
            for (int uu = 0; uu < 2; ++uu)
                if (2 * uu <= it) { const u32x4 mm = {pk[2 * uu][0], pk[2 * uu][1], pk[2 * uu + 1][0], pk[2 * uu + 1][1]}; const bf16x8 mf = __builtin_bit_cast(bf16x8, mm);
#pragma unroll
                    for (int e = 0; e < 2; ++e) { const LAS unsigned char* xp = lds + O_XT + (((ptb + e) * 16 + c16) * 72 + uu * 32 + q4 * 4) * 2;
                        const u32x2 va = *(const LAS u32x2*)xp, vb = *(const LAS u32x2*)(xp + 32); const u32x4 vv = {va.x, va.y, vb.x, vb.y};
                        yacc[e] = __builtin_amdgcn_mfma_f32_16x16x32_bf16(__builtin_bit_cast(bf16x8, vv), mf, yacc[e], 0, 0, 0); } }
            { const size_t tok = (size_t)scan_tok(b, dir, c * 64 + irow);
#pragma unroll
              for (int e = 0; e < 2; ++e) { u32x2 o; o.x = cvt_pk_bf16(yacc[e][0], yacc[e][1]); o.y = cvt_pk_bf16(yacc[e][2], yacc[e][3]);
                  *(u32x2*)(Pm + tok * PW + ycol + (ptb + e) * 16 + q4 * 4) = o; } }
            { const float dl = __expf(cs_last);
#pragma unroll
              for (int pt = 0; pt < 4; ++pt) hacc[pt] = hacc[pt] * dl;
#pragma unroll
              for (int uu = 0; uu < 2; ++uu) {
                  const LAS unsigned char* bp = lds + O_BT + ((w * 16 + c16) * 72 + uu * 32 + q4 * 4) * 2;
                  const u32x2 ba = *(const LAS u32x2*)bp, bb = *(const LAS u32x2*)(bp + 32);
                  const f32x4 cs0 = *(const LAS f32x4*)(lds + O_CS + (uu * 32 + q4 * 4) * 4), cs1 = *(const LAS f32x4*)(lds + O_CS + (uu * 32 + 16 + q4 * 4) * 4);
                  const f32x4 d0 = *(const LAS f32x4*)(lds + O_DT + (uu * 32 + q4 * 4) * 4), d1 = *(const LAS f32x4*)(lds + O_DT + (uu * 32 + 16 + q4 * 4) * 4);
                  u32x4 sb;
                  sb.x = cvt_pk_bf16(bflo(ba.x) * __expf(cs_last - cs0[0]) * d0[0], bfhi(ba.x) * __expf(cs_last - cs0[1]) * d0[1]);
                  sb.y = cvt_pk_bf16(bflo(ba.y) * __expf(cs_last - cs0[2]) * d0[2], bfhi(ba.y) * __expf(cs_last - cs0[3]) * d0[3]);
                  sb.z = cvt_pk_bf16(bflo(bb.x) * __expf(cs_last - cs1[0]) * d1[0], bfhi(bb.x) * __expf(cs_last - cs1[1]) * d1[1]);
                  sb.w = cvt_pk_bf16(bflo(bb.y) * __expf(cs_last - cs1[2]) * d1[2], bfhi(bb.y) * __expf(cs_last - cs1[3]) * d1[3]);
                  const bf16x8 bfr = __builtin_bit_cast(bf16x8, sb);
#pragma unroll
                  for (int pt = 0; pt < 4; ++pt) hacc[pt] = __builtin_amdgcn_mfma_f32_16x16x32_bf16(bfr, xf[pt][uu], hacc[pt], 0, 0, 0); }
#pragma unroll
              for (int pt = 0; pt < 4; ++pt) { u32x2 o; o.x = cvt_pk_bf16(hacc[pt][0], hacc[pt][1]); o.y = cvt_pk_bf16(hacc[pt][2], hacc[pt][3]);
                  *(LAS u32x2*)(Hn + ((pt * 16 + c16) * 136 + w * 16 + q4 * 4) * 2) = o; } }
            __syncthreads();
            if (c + 1 < 36) SCAN_STORE();
            __syncthreads();
        }
#undef SCAN_LOAD
#undef SCAN_STORE
    }
}

__device__ __forceinline__ void phase_ssd_final(KP p, int layer, int ntok) {
    p = fresh(p); unsigned char* wsl = fresh_ws(p); const int tid = opaque_tid();
    const int lane = tid & 63, wv = tid >> 6;
    const bf16_t* U = (const bf16_t*)(wsl + OFF_R1); bf16_t* Pm = (bf16_t*)(wsl + OFF_P);
    const int ch = lane * 16; const float dsk = p->ssd_d[layer * 16 + (lane >> 2)];
    for (int tok = blockIdx.x * 8 + wv; tok < ntok; tok += gridDim.x * 8) {
        bf16_t* row = Pm + (size_t)tok * PW;
        float ys[16]; float ss = 0.f;
#pragma unroll
        for (int hh = 0; hh < 2; ++hh) {
            const u32x4 xv = *(const u32x4*)(U + (size_t)tok * 2048 + ch + hh * 8), yf = *(const u32x4*)(row + CYF + ch + hh * 8), yb = *(const u32x4*)(row + CYB + ch + hh * 8), zs = *(const u32x4*)(row + CZS + ch + hh * 8);
            const unsigned xa[4] = {xv.x, xv.y, xv.z, xv.w}, fa[4] = {yf.x, yf.y, yf.z, yf.w}, ba[4] = {yb.x, yb.y, yb.z, yb.w}, za[4] = {zs.x, zs.y, zs.z, zs.w};
#pragma unroll
            for (int e = 0; e < 4; ++e) { const float v0 = (dsk * bflo(xa[e]) + bflo(fa[e]) + bflo(ba[e])) * silu_f(bflo(za[e])); const float v1 = (dsk * bfhi(xa[e]) + bfhi(fa[e]) + bfhi(ba[e])) * silu_f(bfhi(za[e]));
                ys[hh * 8 + e * 2] = v0; ys[hh * 8 + e * 2 + 1] = v1; ss += v0 * v0 + v1 * v1; }
        }
        ss = wave_sum(ss);
        const float rstd = rsqrtf(ss * (1.f / 1024.f) + 1e-6f);
        const float* nw = p->ssd_norm_w + layer * 1024 + ch;
#pragma unroll
        for (int hh = 0; hh < 2; ++hh) { const f32x4 w0 = *(const f32x4*)(nw + hh * 8), w1 = *(const f32x4*)(nw + hh * 8 + 4);
            u32x4 o; o.x = cvt_pk_bf16(ys[hh * 8 + 0] * rstd * w0[0], ys[hh * 8 + 1] * rstd * w0[1]); o.y = cvt_pk_bf16(ys[hh * 8 + 2] * rstd * w0[2], ys[hh * 8 + 3] * rstd * w0[3]);
            o.z = cvt_pk_bf16(ys[hh * 8 + 4] * rstd * w1[0], ys[hh * 8 + 5] * rstd * w1[1]); o.w = cvt_pk_bf16(ys[hh * 8 + 6] * rstd * w1[2], ys[hh * 8 + 7] * rstd * w1[3]);
            *(u32x4*)(row + CA3 + ch + hh * 8) = o; }
    }
}

__global__ void __launch_bounds__(512, 2) fwd_megakernel(Params p_unused) {
    extern __shared__ __attribute__((aligned(16))) unsigned char smem[];
    KP p = (KP)__builtin_amdgcn_kernarg_segment_ptr();
    cg::grid_group grid = cg::this_grid();
    LAS unsigned char* lds = (LAS unsigned char*)smem;
#define WSF unsigned char* ws = fresh_ws(p); bf16_t* Pm = (bf16_t*)(ws + OFF_P); bf16_t* hbuf = (bf16_t*)(ws + OFF_R1); bf16_t* M1 = (bf16_t*)(ws + OFF_R2); \
    bf16_t* TTlat = (bf16_t*)(ws + OFF_R2); bf16_t* TTctx = (bf16_t*)(ws + OFF_R2 + TTCTX_OFF); float* xl = (float*)(ws + OFF_XL); const float* mod = (const float*)(ws + OFF_MOD); \
    (void)Pm; (void)hbuf; (void)M1; (void)TTlat; (void)TTctx; (void)xl; (void)mod;
    for (int l = 0; l < 2; ++l) {
        const int nMt = l == 0 ? 72 : 64;
        if (l == 0) { phase_ada(p, smem); phase_dft(p); }
        phase_wprep(p, l, smem);
        if (l == 0) grid.sync();
        phase_norm(p, l);
        grid.sync();
        { WSF InSched S; S.H = (const char*)hbuf; S.W = (const char*)(ws + OFF_WINT); S.WV = (const char*)(ws + OFF_WVT); S.per = l == 0 ? 57 : 13; S.nctx = 8 * S.per; S.G = (int)gridDim.x; S.c = (int)blockIdx.x;
          EpiIn E{Pm, (bf16_t*)(ws + OFF_VT)}; gemm_phase(lds, 2048, 2048, 2048, S, E); }
        grid.sync();
        { WSF GSched S = make_sched(ws + OFF_W2T, 1024, Pm + CUF, PW, 8, nMt); EpiTT E{TTlat, TTctx}; gemm_phase(lds, 1024, PW, 1024, S, E); }
        phase_conv(p, l, smem);
        phase_attn(p, l, smem);
        grid.sync();
        { WSF GSched S = make_sched(ws + OFF_DL, 4096, TTlat, 4096, 8, 32); EpiFb E{Pm, 0, 2048}; gemm_phase(lds, 4096, 4096, 4096, S, E); }
        if (l == 0) { WSF GSched S = make_sched(ws + OFF_DC, 512, TTctx, 512, 1, 32); EpiFb E{Pm, NLAT, 256}; gemm_phase(lds, 512, 512, 512, S, E); }
        phase_scan(p, smem);
        grid.sync();
        phase_ssd_final(p, l, l == 0 ? NTOK : NLAT);
        grid.sync();
        { WSF GSched S = make_sched(Pm, PW, ws + OFF_WCAT, 3072, nMt, 8); S.nZ = 3; S.az_lin = CA2 * 2; S.az_x2 = (CA3 - 2 * CA2) * 2; S.bz_lin = 2048;
          EpiMerge E{Pm, (float*)(ws + OFF_R1), M1}; gemm_phase(lds, PW, 3072, 1024, S, E); }
        grid.sync();
        { WSF GSched S = make_sched(M1, 2048, ws + OFF_WOUT, 2048, nMt, 8);
          EpiOut E{l == 0 ? p->x : xl, l == 0 ? p->ctx : xl + (size_t)NLAT * 2048, xl, mod + (size_t)l * 9 * 6144}; gemm_phase(lds, 2048, 2048, 2048, S, E); }
        grid.sync();
    }
    phase_norm(p, 2);
}

extern "C" void kernel_launch(void* const* d_in, const int* in_sizes, int n_in, void* d_out, int out_size, void* d_ws, size_t ws_size, hipStream_t stream) {
    static int grid_blocks = 0;
    if (grid_blocks == 0) {
        if (n_in != 21 || ws_size < WS_END) { fprintf(stderr, "kernel_launch: need 21 inputs and >= %zu bytes of workspace (got %d, %zu)\n", (size_t)WS_END, n_in, ws_size); grid_blocks = -1; return; }
        int dev = 0, cus = 0, per_cu = 0;
        hipGetDevice(&dev); hipDeviceGetAttribute(&cus, hipDeviceAttributeMultiprocessorCount, dev);
        if (hipFuncSetAttribute((const void*)fwd_megakernel, hipFuncAttributeMaxDynamicSharedMemorySize, LDS_BYTES) != hipSuccess) { fprintf(stderr, "kernel_launch: hipFuncSetAttribute failed\n"); grid_blocks = -1; return; }
        if (hipOccupancyMaxActiveBlocksPerMultiprocessor(&per_cu, (const void*)fwd_megakernel, 512, LDS_BYTES) != hipSuccess || per_cu < 1) { fprintf(stderr, "kernel_launch: occupancy query failed (%d)\n", per_cu); per_cu = 1; (void)hipGetLastError(); }
        grid_blocks = cus * 1;
    }
    if (grid_blocks < 0) return;
    Params p{};
    const float** pp = (const float**)&p;
    for (int i = 0; i < 21; ++i) pp[i] = (const float*)d_in[i];
    p.out = (float*)d_out; p.ws = (unsigned char*)d_ws;
    void* args[] = {&p};
    hipError_t e = hipLaunchCooperativeKernel((const void*)fwd_megakernel, dim3(grid_blocks), dim3(512), args, LDS_BYTES, stream);
    if (e != hipSuccess) fprintf(stderr, "cooperative launch failed: %s (grid %d)\n", hipGetErrorString(e), grid_blocks);
}
```

```cpp
#include <hip/hip_runtime.h>
#include <hip/hip_cooperative_groups.h>
#include <cstdio>
namespace cg = cooperative_groups;

#define LAS __attribute__((address_space(3)))
typedef unsigned short bf16_t;
typedef short bf16x8 __attribute__((ext_vector_type(8)));
typedef float f32x4 __attribute__((ext_vector_type(4)));
typedef unsigned u32x4 __attribute__((ext_vector_type(4)));
typedef unsigned u32x2 __attribute__((ext_vector_type(2)));

constexpr int NB = 8, SEQ = 2048, CTXL = 256, NLAT = NB * SEQ, NCTX = NB * CTXL, NTOK = NLAT + NCTX;
constexpr int INW = 15392;
constexpr int PW = 14592;
constexpr int CQ = 0, CK = 1024, CZNA = 2048, CUF = 3072, CZF = 4096, CXBC = 5120, CZS = 7168, CGNA = 8192, CDT = 14336;
constexpr int CA1 = CQ, CA2 = CK, CA3 = CUF, CYF = CXBC, CYB = CXBC + 1024;

constexpr size_t OFF_WINT = 0;
constexpr size_t OFF_WVT  = OFF_WINT + (size_t)PW * 2048 * 2;
constexpr size_t OFF_WCAT = OFF_WVT + (size_t)1024 * 2048 * 2;
constexpr size_t OFF_WOUT = OFF_WCAT + (size_t)2048 * 3072 * 2;
constexpr size_t OFF_W2T  = OFF_WOUT + (size_t)2048 * 2048 * 2;
constexpr size_t OFF_P    = OFF_W2T + (size_t)2048 * 1024 * 2;
constexpr size_t OFF_VT   = OFF_P + (size_t)NTOK * PW * 2;
constexpr size_t OFF_R1   = OFF_VT + (size_t)1024 * NTOK * 2;
constexpr size_t OFF_XL   = OFF_R1 + (size_t)NTOK * 2048 * 2;
constexpr size_t OFF_R2   = OFF_XL + (size_t)NTOK * 2048 * 4;
constexpr size_t OFF_DL   = OFF_R2 + (size_t)NTOK * 2048 * 2;
constexpr size_t OFF_DC   = OFF_DL + (size_t)2048 * 4096 * 2;
constexpr size_t OFF_DTV  = OFF_DC + (size_t)256 * 512 * 2;
constexpr size_t OFF_DEC  = OFF_DTV + (size_t)NTOK * 32 * 4;
constexpr size_t OFF_MOD  = OFF_DEC + (size_t)NTOK * 32 * 4;
constexpr size_t WS_END   = OFF_MOD + (size_t)2 * 9 * 6144 * 4;
constexpr size_t TTCTX_OFF = (size_t)8 * 2048 * 2048 * 2;
constexpr int VTB = 2304;
constexpr int LDS_BYTES = 160768;

#ifndef PROBE_MASK
#define PROBE_MASK 0
#endif
struct Params {
    const float *x, *c, *ctx, *c_ctx, *w_ada, *b_ada, *norm_w, *w_in, *rpb, *four_w, *conv_w, *conv_b, *dt_bias, *a_log, *ssd_d,
                *ssd_norm_w, *wb_na, *wb_four, *wb_ssd, *w_out, *final_norm_w;
    float* out; unsigned char* ws;
};

#define GL __attribute__((address_space(1)))
struct ParamsG {
    const GL float *x, *c, *ctx, *c_ctx, *w_ada, *b_ada, *norm_w, *w_in, *rpb, *four_w, *conv_w, *conv_b, *dt_bias, *a_log, *ssd_d,
                   *ssd_norm_w, *wb_na, *wb_four, *wb_ssd, *w_out, *final_norm_w;
    GL float* out; GL unsigned char* ws;
};
static_assert(sizeof(ParamsG) == sizeof(Params), "layout");
typedef const __attribute__((address_space(4))) ParamsG* KP;
__device__ __forceinline__ float bf2f(unsigned v) { return __uint_as_float(v << 16); }
__device__ __forceinline__ float bflo(unsigned v) { return __uint_as_float(v << 16); }
__device__ __forceinline__ float bfhi(unsigned v) { return __uint_as_float(v & 0xffff0000u); }
typedef __bf16 bf16x2_t __attribute__((ext_vector_type(2)));
typedef float f32x2_t __attribute__((ext_vector_type(2)));
__device__ __forceinline__ unsigned cvt_pk_bf16(float lo, float hi) { const f32x2_t f = {lo, hi}; const bf16x2_t r = __builtin_convertvector(f, bf16x2_t); return __builtin_bit_cast(unsigned, r); }
__device__ __forceinline__ float sigm_f(float x) { return __builtin_amdgcn_rcpf(1.f + __builtin_amdgcn_exp2f(x * -1.4426950408889634f)); }
__device__ __forceinline__ float silu_f(float x) { return x * sigm_f(x); }
__device__ __forceinline__ int opaque_tid() { const int w = __builtin_amdgcn_readfirstlane((int)threadIdx.x >> 6);
    int t = w * 64 + (int)__builtin_amdgcn_mbcnt_hi(~0u, __builtin_amdgcn_mbcnt_lo(~0u, 0u)); asm volatile("" : "+v"(t)); return t; }
__device__ __forceinline__ KP fresh(KP p) { asm volatile("" : "+s"(p)); return p; }
__device__ __forceinline__ unsigned char* fresh_ws(KP p) { GL unsigned char* w = p->ws; asm volatile("" : "+s"(w)); return (unsigned char*)w; }
__device__ __forceinline__ float wave_sum(float v) {
#pragma unroll
    for (int o = 32; o >= 1; o >>= 1) v += __shfl_xor(v, o);
    return v;
}

constexpr int BM = 256, BK = 64, HALF = 128, HTB = HALF * BK * 2, NXCD = 8, WGM = 8;
__device__ __forceinline__ int lds_byte(int r, int c) { const int st = (r >> 4) * 2 + (c >> 5), rr = r & 15, cc = c & 31, ob = rr * 64 + cc * 2; return st * 1024 + (ob ^ (((ob >> 9) & 1) << 5)); }
__device__ __forceinline__ void stage_rc(int b, int& R, int& C) { const int st = b / 1024, sb = b % 1024, swz = sb ^ (((sb >> 9) & 1) << 5); R = (st >> 1) * 16 + swz / 64; C = (st & 1) * 32 + (swz % 64) / 2; }
__device__ __forceinline__ int perm32(int rho) { const int n = rho >> 4, i = rho & 15; return 8 * (i >> 2) + 4 * n + (i & 3); }

struct Unit { const char* a; const char* b; int pm, pn, z; };
struct GSched {
    const char* A; const char* B; unsigned a_tile, b_tile; int az_lin, az_x2, bz_lin; int nM, nN, nZ, G, c;
    __device__ __forceinline__ bool next(int i, Unit& u) const {
        const int ti = i / nZ, z = i - ti * nZ;
        const long L = (long)ti * G + c; const int nwg = nM * nN; if (L >= nwg) return false;
        int wgid = (int)L; { const int q = nwg / NXCD, r = nwg % NXCD, xcd = wgid % NXCD, off = wgid / NXCD; wgid = (xcd < r ? xcd * (q + 1) : r * (q + 1) + (xcd - r) * q) + off; }
        const int nig = WGM * nN, gid = wgid / nig, fm = gid * WGM, gsz = (nM - fm) < WGM ? (nM - fm) : WGM;
        u.pm = fm + ((wgid % nig) % gsz); u.pn = (wgid % nig) / gsz; u.z = z;
        u.a = A + (size_t)u.pm * a_tile + (size_t)(z * az_lin + (z == 2 ? az_x2 : 0));
        u.b = B + (size_t)u.pn * b_tile + (size_t)(z * bz_lin);
        return true;
    }
};
__device__ __forceinline__ GSched make_sched(const void* A, int lda, const void* B, int ldb, int nM, int nN) {
    GSched S; S.A = (const char*)A; S.B = (const char*)B; S.a_tile = (unsigned)(BM * lda * 2); S.b_tile = (unsigned)(BM * ldb * 2);
    S.az_lin = 0; S.az_x2 = 0; S.bz_lin = 0; S.nM = nM; S.nN = nN; S.nZ = 1; S.G = (int)gridDim.x; S.c = (int)blockIdx.x; return S;
}

struct InSched {
    const char* H; const char* W; const char* WV; int nctx, per, G, c;
    __device__ __forceinline__ bool next(int i, Unit& u) const {
        long L = (long)i * G + c;
        if (L < 3648) { const int nwg = 3648, nM = 64, nN = 57;
            int wgid = (int)L; { const int q = nwg / NXCD, r = nwg % NXCD, xcd = wgid % NXCD, off = wgid / NXCD; wgid = (xcd < r ? xcd * (q + 1) : r * (q + 1) + (xcd - r) * q) + off; }
            const int nig = WGM * nN, gid = wgid / nig, fm = gid * WGM, gsz = (nM - fm) < WGM ? (nM - fm) : WGM;
            u.pm = fm + ((wgid % nig) % gsz); u.pn = (wgid % nig) / gsz; u.z = 0;
            u.a = H + (size_t)u.pm * 1048576; u.b = W + (size_t)u.pn * 1048576; return true; }
        L -= 3648;
        if (L < nctx) { const int q = (int)L / per, j = (int)L % per; u.pm = 64 + q; u.pn = per == 57 ? j : (j < 4 ? 4 + j : (j < 12 ? 16 + j : 56)); u.z = 0;
            u.a = H + (size_t)u.pm * 1048576; u.b = W + (size_t)u.pn * 1048576; return true; }
        L -= nctx; if (L >= 288) return false;
        u.pm = (int)L & 3; u.pn = (int)L >> 2; u.z = 1; u.a = WV + (size_t)u.pm * 1048576; u.b = H + (size_t)u.pn * 1048576; return true;
    }
};

template <class Epi, class Sched>
__device__ __forceinline__ void gemm_phase(LAS unsigned char* lds, const int lda, const int ldb, const int K, const Sched& S, const Epi& E) {
    const int tid = opaque_tid(), wid = __builtin_amdgcn_readfirstlane(tid >> 6), lane = tid & 63, wr = wid >> 2, wc = wid & 3, fr = lane & 15, fq = lane >> 4;
    const int nt = K / BK;
    unsigned voffA[2], voffB[2];
#pragma unroll
    for (int i = 0; i < 2; ++i) { int R, C; stage_rc(tid * 16 + i * 8192, R, C); const int Rb = Epi::PERM ? ((R & ~31) + perm32(R & 31)) : R;
        voffA[i] = (unsigned)(R * lda + C) * 2u; voffB[i] = (unsigned)(Rb * ldb + C) * 2u; }
    const size_t kstep = (size_t)(BK * 2);
    const size_t hstepA = (size_t)HALF * lda * 2, hstepB = (size_t)HALF * ldb * 2;
    const unsigned ldsw = (unsigned)wid * 1024u;
    const int aoff = lds_byte(wr * 64 + fr, fq * 8), boff = lds_byte(wc * 32 + fr, fq * 8);
#define PG8_SA(b, h) (((b) * 2 + (h)) * HTB)
#define PG8_SB(b, h) ((4 + (b) * 2 + (h)) * HTB)
#define PG8_STAGE(bufoff, gbase, voff) do { _Pragma("unroll") for (int _i = 0; _i < 2; ++_i) \
        __builtin_amdgcn_global_load_lds((const unsigned*)((const char*)(gbase) + (voff)[_i]), (LAS unsigned*)(lds + (bufoff) + ldsw + _i * 8192), 16, 0, 0); } while (0)
#define PG8_LDA(dst, b, h) do { _Pragma("unroll") for (int m = 0; m < 4; ++m) _Pragma("unroll") for (int k = 0; k < 2; ++k) dst[m][k] = *(const LAS bf16x8*)(lds + PG8_SA(b, h) + aoff + m * 2048 + k * 1024); } while (0)
#define PG8_LDB(dst, b, h) do { _Pragma("unroll") for (int n = 0; n < 2; ++n) _Pragma("unroll") for (int k = 0; k < 2; ++k) dst[n][k] = *(const LAS bf16x8*)(lds + PG8_SB(b, h) + boff + n * 2048 + k * 1024); } while (0)
#define PG8_MMA(ai, bj, At, Bt) do { __builtin_amdgcn_s_setprio(1); _Pragma("unroll") for (int m = 0; m < 4; ++m) _Pragma("unroll") for (int n = 0; n < 2; ++n) _Pragma("unroll") for (int k = 0; k < 2; ++k) \
        acc[ai][bj][m][n] = __builtin_amdgcn_mfma_f32_16x16x32_bf16(Bt[n][k], At[m][k], acc[ai][bj][m][n], 0, 0, 0); __builtin_amdgcn_s_setprio(0); } while (0)
#define PG8_WAIT_V(n) asm volatile("s_waitcnt vmcnt(" #n ")" ::: "memory")
#define PG8_WAIT_L(n) asm volatile("s_waitcnt lgkmcnt(" #n ")" ::: "memory")
#define PG8_BAR __builtin_amdgcn_s_barrier()
#define PG8_SCHED __builtin_amdgcn_sched_barrier(0)
    Unit cur, nxt; int ui = 0;
    if (!S.next(0, cur)) return;
    f32x4 acc[2][2][4][2];
#pragma unroll
    for (int a = 0; a < 2; ++a)
#pragma unroll
        for (int b = 0; b < 2; ++b)
#pragma unroll
            for (int m = 0; m < 4; ++m)
#pragma unroll
                for (int n = 0; n < 2; ++n) acc[a][b][m][n] = (f32x4){0.f, 0.f, 0.f, 0.f};
    bf16x8 At[4][2], B0[2][2], B1[2][2];
    const char* cA = cur.a; const char* cB = cur.b;
    PG8_STAGE(PG8_SB(0, 0), cB, voffB); PG8_STAGE(PG8_SA(0, 0), cA, voffA); PG8_STAGE(PG8_SB(0, 1), cB + hstepB, voffB); PG8_STAGE(PG8_SA(0, 1), cA + hstepA, voffA);
    if (wr == 1) PG8_BAR;
    PG8_WAIT_V(4); PG8_BAR;
    PG8_STAGE(PG8_SB(1, 0), cB + kstep, voffB); PG8_STAGE(PG8_SA(1, 0), cA + kstep, voffA); PG8_STAGE(PG8_SB(1, 1), cB + hstepB + kstep, voffB);
    PG8_WAIT_V(6); PG8_BAR;
    for (;;) {
        const bool has_next = S.next(ui + 1, nxt);
        const char* nA = has_next ? nxt.a : cA; const char* nB = has_next ? nxt.b : cB;
        for (int t = 0; t < nt; t += 2) {
            const bool last = (t == nt - 2);
            const char* a1 = cA + (size_t)(t + 1) * kstep;
            const char* a2 = last ? nA : cA + (size_t)(t + 2) * kstep; const char* b2 = last ? nB : cB + (size_t)(t + 2) * kstep;
            const char* a3 = a2 + kstep; const char* b3 = b2 + kstep;
            PG8_LDB(B0, 0, 0); PG8_SCHED; PG8_LDA(At, 0, 0); PG8_STAGE(PG8_SA(1, 1), a1 + hstepA, voffA);
            PG8_WAIT_L(8); PG8_BAR; PG8_WAIT_L(0); PG8_MMA(0, 0, At, B0); PG8_BAR; PG8_SCHED;
            PG8_LDB(B1, 0, 1); PG8_STAGE(PG8_SB(0, 0), b2, voffB);
            PG8_BAR; PG8_WAIT_L(0); PG8_MMA(0, 1, At, B1); PG8_BAR;
            PG8_LDA(At, 0, 1); PG8_STAGE(PG8_SA(0, 0), a2, voffA);
            PG8_BAR; PG8_WAIT_L(0); PG8_MMA(1, 0, At, B0); PG8_BAR; PG8_SCHED;
            PG8_STAGE(PG8_SB(0, 1), b2 + hstepB, voffB);
            PG8_WAIT_V(6); PG8_BAR; PG8_MMA(1, 1, At, B1); PG8_BAR;
            PG8_LDB(B0, 1, 0); PG8_SCHED; PG8_LDA(At, 1, 0); PG8_STAGE(PG8_SA(0, 1), a2 + hstepA, voffA);
            PG8_WAIT_L(8); PG8_BAR; PG8_WAIT_L(0); PG8_MMA(0, 0, At, B0); PG8_BAR; PG8_SCHED;
            PG8_LDB(B1, 1, 1); PG8_STAGE(PG8_SB(1, 0), b3, voffB);
            PG8_BAR; PG8_WAIT_L(0); PG8_MMA(0, 1, At, B1); PG8_BAR;
            PG8_LDA(At, 1, 1); PG8_STAGE(PG8_SA(1, 0), a3, voffA);
            PG8_BAR; PG8_WAIT_L(0); PG8_MMA(1, 0, At, B0); PG8_BAR; PG8_SCHED;
            PG8_STAGE(PG8_SB(1, 1), b3 + hstepB, voffB);
            PG8_WAIT_V(6); PG8_BAR; PG8_MMA(1, 1, At, B1); PG8_BAR;
        }
        E(acc, cur, wr, wc, fr, fq);
        if (!has_next) break;
#pragma unroll
        for (int a = 0; a < 2; ++a)
#pragma unroll
            for (int b = 0; b < 2; ++b)
#pragma unroll
                for (int m = 0; m < 4; ++m)
#pragma unroll
                    for (int n = 0; n < 2; ++n) acc[a][b][m][n] = (f32x4){0.f, 0.f, 0.f, 0.f};
        cur = nxt; cA = nA; cB = nB; ++ui;
    }
    PG8_WAIT_V(0);
    if (wr == 0) PG8_BAR;
    PG8_BAR;
#undef PG8_SA
#undef PG8_SB
#undef PG8_STAGE
#undef PG8_LDA
#undef PG8_LDB
#undef PG8_MMA
#undef PG8_WAIT_V
#undef PG8_WAIT_L
#undef PG8_BAR
#undef PG8_SCHED
}

struct EpiStore {
    static constexpr bool PERM = true; bf16_t* O; size_t ldc;
    __device__ __forceinline__ void operator()(const f32x4 (&acc)[2][2][4][2], const Unit& u, int wr, int wc, int fr, int fq) const {
        const int row0 = u.pm * BM + wr * 64 + fr, col0 = u.pn * BM + wc * 32 + 8 * fq;
#pragma unroll
        for (int ai = 0; ai < 2; ++ai)
#pragma unroll
            for (int m = 0; m < 4; ++m) { bf16_t* rowp = O + (size_t)(row0 + ai * HALF + m * 16) * ldc + col0;
#pragma unroll
                for (int bj = 0; bj < 2; ++bj) { const f32x4 v0 = acc[ai][bj][m][0], v1 = acc[ai][bj][m][1];
                    u32x4 w; w.x = cvt_pk_bf16(v0[0], v0[1]); w.y = cvt_pk_bf16(v0[2], v0[3]); w.z = cvt_pk_bf16(v1[0], v1[1]); w.w = cvt_pk_bf16(v1[2], v1[3]);
                    *(u32x4*)(rowp + bj * HALF) = w; } }
    }
};
__device__ __forceinline__ int uu_row(int tok) {
    int l, L, base;
    if (tok < NLAT) { l = tok & 2047; L = 2048; base = tok & ~2047; } else { const int t2 = tok - NLAT; l = t2 & 255; L = 256; base = NLAT + (t2 & ~255); }
    const int h = L >> 1; const int s = l < h ? 0 : 1; const int i = l < h ? l : (l == h ? 0 : L - l);
    return base + (i >> 7) * 256 + s * 128 + (i & 127);
}
struct EpiIn {
    static constexpr bool PERM = true; bf16_t* Pm; bf16_t* VT; bf16_t* UU;
    __device__ __forceinline__ void operator()(const f32x4 (&acc)[2][2][4][2], const Unit& u, int wr, int wc, int fr, int fq) const {
        const int row0 = u.pm * BM + wr * 64 + fr, col0 = u.pn * BM + wc * 32 + 8 * fq;
        const bool isuf = u.z == 0 && u.pn >= CUF / 256 && u.pn < CUF / 256 + 4;
        bf16_t* O = u.z ? VT + (u.pn < 64 ? (size_t)(u.pn >> 3) * 1024 * VTB + (u.pn & 7) * 256 : (size_t)(u.pn - 64) * 1024 * VTB + 2048) - (size_t)u.pn * BM : Pm;
        const size_t ldc = u.z ? (size_t)VTB : (size_t)PW;
#pragma unroll
        for (int ai = 0; ai < 2; ++ai)
#pragma unroll
            for (int m = 0; m < 4; ++m) { const int row = row0 + ai * HALF + m * 16;
                bf16_t* rowp = isuf ? UU + (size_t)uu_row(row) * 1024 + (col0 - CUF) : O + (size_t)row * ldc + col0;
#pragma unroll
                for (int bj = 0; bj < 2; ++bj) { const f32x4 v0 = acc[ai][bj][m][0], v1 = acc[ai][bj][m][1];
                    u32x4 w; w.x = cvt_pk_bf16(v0[0], v0[1]); w.y = cvt_pk_bf16(v0[2], v0[3]); w.z = cvt_pk_bf16(v1[0], v1[1]); w.w = cvt_pk_bf16(v1[2], v1[3]);
                    *(u32x4*)(rowp + bj * HALF) = w; } }
    }
};
struct EpiTT {
    static constexpr bool PERM = true; bf16_t* TTlat; bf16_t* TTctx;
    __device__ __forceinline__ void operator()(const f32x4 (&acc)[2][2][4][2], const Unit& u, int wr, int wc, int fr, int fq) const {
        const int row0 = u.pm * BM + wr * 64 + fr; const int cs = fr & 1; const int j0 = wc * 32 + 8 * fq;
        bf16_t* base; int L, chunk;
        if (u.pn < 64) { L = 2048; chunk = u.pn & 7; base = TTlat + (size_t)(u.pn >> 3) * 1024 * 2048; }
        else { L = 256; chunk = 0; base = TTctx + (size_t)(u.pn - 64) * 1024 * 256; }
        const bool first = chunk == 0 && j0 == 0;
#pragma unroll
        for (int ai = 0; ai < 2; ++ai)
#pragma unroll
            for (int m = 0; m < 4; ++m) { const int ch = (row0 + ai * HALF + m * 16) >> 1;
                bf16_t* rowp = base + (size_t)ch * L + (cs ? (L >> 1) : 0) + chunk * 128 + j0;
                const float nyq = __shfl_xor(acc[ai][1][m][0][0], 1);
#pragma unroll
                for (int n = 0; n < 2; ++n) { const f32x4 a = acc[ai][0][m][n], bb = acc[ai][1][m][n];
                    f32x4 v = cs ? a - bb : a + bb;
                    if (n == 0 && first) v[0] = cs ? nyq : a[0];
                    u32x2 w; w.x = cvt_pk_bf16(v[0], v[1]); w.y = cvt_pk_bf16(v[2], v[3]); *(u32x2*)(rowp + n * 4) = w; } }
    }
};
struct EpiFb {
    static constexpr bool PERM = true; bf16_t* Pm; int tok0; int L;
    __device__ __forceinline__ void operator()(const f32x4 (&acc)[2][2][4][2], const Unit& u, int wr, int wc, int fr, int fq) const {
        const int b = u.pn >> 2, ch0 = (u.pn & 3) * 256 + wc * 32 + 8 * fq;
        const int row0 = u.pm * BM + wr * 64 + fr;
#pragma unroll
        for (int ai = 0; ai < 2; ++ai)
#pragma unroll
            for (int m = 0; m < 4; ++m) { asm volatile("" ::: "memory"); bf16_t* rowp = Pm + (size_t)(tok0 + b * L + row0 + ai * HALF + m * 16) * PW + ch0;
#pragma unroll
                for (int bj = 0; bj < 2; ++bj) { const f32x4 v0 = acc[ai][bj][m][0], v1 = acc[ai][bj][m][1];
                    const u32x4 z = *(const u32x4*)(rowp + CZF + bj * HALF);
                    u32x4 w; w.x = cvt_pk_bf16(v0[0] * silu_f(bflo(z.x)), v0[1] * silu_f(bfhi(z.x))); w.y = cvt_pk_bf16(v0[2] * silu_f(bflo(z.y)), v0[3] * silu_f(bfhi(z.y)));
                    w.z = cvt_pk_bf16(v1[0] * silu_f(bflo(z.z)), v1[1] * silu_f(bfhi(z.z))); w.w = cvt_pk_bf16(v1[2] * silu_f(bflo(z.w)), v1[3] * silu_f(bfhi(z.w)));
                    *(u32x4*)(rowp + CA2 + bj * HALF) = w; } }
    }
};
struct EpiMerge {
    static constexpr bool PERM = true; const bf16_t* Pm; float* scratch; bf16_t* M1;
    __device__ __forceinline__ void operator()(const f32x4 (&acc)[2][2][4][2], const Unit& u, int wr, int wc, int fr, int fq) const {
        const int row0 = u.pm * BM + wr * 64 + fr, col0 = u.pn * BM + wc * 32 + 8 * fq;
        unsigned* sp = (unsigned*)scratch + (size_t)blockIdx.x * 32768 + (size_t)opaque_tid() * 4;
        const bf16_t* gp = Pm + (size_t)row0 * PW + CGNA + u.z * 2048 + col0;
        bf16_t* mp = M1 + (size_t)row0 * 2048 + col0;
        const int z = u.z;
#pragma unroll
        for (int ai = 0; ai < 2; ++ai)
#pragma unroll
            for (int m = 0; m < 4; ++m) { asm volatile("" : "+v"(sp));
                const int ro = ai * HALF + m * 16;
                const u32x4 g0 = *(const u32x4*)(gp + (size_t)ro * PW), g1 = *(const u32x4*)(gp + (size_t)ro * PW + HALF);
                u32x4 t0 = {0u, 0u, 0u, 0u}, t1 = {0u, 0u, 0u, 0u};
                if (z > 0) { t0 = *(const u32x4*)sp; t1 = *(const u32x4*)(sp + 2048); }
#pragma unroll
                for (int bj = 0; bj < 2; ++bj) { const u32x4 g = bj ? g1 : g0; const u32x4 t = bj ? t1 : t0; const f32x4 v0 = acc[ai][bj][m][0], v1 = acc[ai][bj][m][1];
                    u32x4 w;
                    w.x = cvt_pk_bf16(bflo(t.x) + v0[0] * sigm_f(bflo(g.x)), bfhi(t.x) + v0[1] * sigm_f(bfhi(g.x))); w.y = cvt_pk_bf16(bflo(t.y) + v0[2] * sigm_f(bflo(g.y)), bfhi(t.y) + v0[3] * sigm_f(bfhi(g.y)));
                    w.z = cvt_pk_bf16(bflo(t.z) + v1[0] * sigm_f(bflo(g.z)), bfhi(t.z) + v1[1] * sigm_f(bfhi(g.z))); w.w = cvt_pk_bf16(bflo(t.w) + v1[2] * sigm_f(bflo(g.w)), bfhi(t.w) + v1[3] * sigm_f(bfhi(g.w)));
                    if (z < 2) *(u32x4*)(sp + bj * 2048) = w; else *(u32x4*)(mp + (size_t)ro * 2048 + bj * HALF) = w; }
                sp += 4096; }
    }
};
struct EpiOut {
    static constexpr bool PERM = true; bf16_t* D; const float* mod;
    __device__ __forceinline__ void operator()(const f32x4 (&acc)[2][2][4][2], const Unit& u, int wr, int wc, int fr, int fq) const {
        const int row0 = u.pm * BM + wr * 64 + fr, col0 = u.pn * BM + wc * 32 + 8 * fq;
        const int vec = u.pm < 64 ? (u.pm >> 3) : 8;
        const float* gp = mod + (size_t)vec * 6144 + 4096 + col0;
        f32x4 gv[2][2];
#pragma unroll
        for (int bj = 0; bj < 2; ++bj)
#pragma unroll
            for (int n = 0; n < 2; ++n) gv[bj][n] = *(const f32x4*)(gp + bj * HALF + n * 4);
#pragma unroll
        for (int ai = 0; ai < 2; ++ai)
#pragma unroll
            for (int m = 0; m < 4; ++m) { bf16_t* rowp = D + (size_t)(row0 + ai * HALF + m * 16) * 2048 + col0;
#pragma unroll
                for (int bj = 0; bj < 2; ++bj) { const f32x4 v0 = acc[ai][bj][m][0] * gv[bj][0], v1 = acc[ai][bj][m][1] * gv[bj][1];
                    u32x4 w; w.x = cvt_pk_bf16(v0[0], v0[1]); w.y = cvt_pk_bf16(v0[2], v0[3]); w.z = cvt_pk_bf16(v1[0], v1[1]); w.w = cvt_pk_bf16(v1[2], v1[3]);
                    *(u32x4*)(rowp + bj * HALF) = w; } }
    }
};

__device__ __forceinline__ void phase_ada(KP p, unsigned char* smem) {
    p = fresh(p);
    float* s = (float*)smem; float* red = s + 9 * 2048; float* mod = (float*)(fresh_ws(p) + OFF_MOD);
    const int tid = opaque_tid();
    for (int i = tid; i < 9 * 2048; i += 512) { const int v = i >> 11, k = i & 2047; const float cv = v < 8 ? ((const float*)p->c)[v * 2048 + k] : ((const float*)p->c_ctx)[k]; s[i] = silu_f(cv); }
    __syncthreads();
    for (int u = blockIdx.x; u < 192; u += gridDim.x) {
        const int l = u / 96, cgp = u % 96, cl = tid & 63, ks = tid >> 6;
        const float* w = ((const float*)p->w_ada) + (size_t)l * 2048 * 6144 + cgp * 64 + cl;
        float a0 = 0, a1 = 0, a2 = 0, a3 = 0, a4 = 0, a5 = 0, a6 = 0, a7 = 0, a8 = 0;
#pragma unroll 4
        for (int k = ks * 256; k < ks * 256 + 256; k += 4) {
            const float w0 = w[(size_t)k * 6144], w1 = w[(size_t)(k + 1) * 6144], w2 = w[(size_t)(k + 2) * 6144], w3 = w[(size_t)(k + 3) * 6144];
#define ADA_ACC(acc, v) do { const f32x4 sv_ = *(const f32x4*)(s + (v) * 2048 + k); acc += sv_[0] * w0 + sv_[1] * w1 + sv_[2] * w2 + sv_[3] * w3; } while (0)
            ADA_ACC(a0, 0); ADA_ACC(a1, 1); ADA_ACC(a2, 2); ADA_ACC(a3, 3); ADA_ACC(a4, 4); ADA_ACC(a5, 5); ADA_ACC(a6, 6); ADA_ACC(a7, 7); ADA_ACC(a8, 8);
#undef ADA_ACC
        }
        float* rp = red + ks * 9 * 64 + cl;
        rp[0] = a0; rp[64] = a1; rp[128] = a2; rp[192] = a3; rp[256] = a4; rp[320] = a5; rp[384] = a6; rp[448] = a7; rp[512] = a8;
        __syncthreads();
        for (int i = tid; i < 9 * 64; i += 512) { float t = 0;
#pragma unroll
            for (int k2 = 0; k2 < 8; ++k2) t += red[k2 * 576 + i];
            const int v = i >> 6, col = cgp * 64 + (i & 63); mod[(size_t)(l * 9 + v) * 6144 + col] = t + ((const float*)p->b_ada)[l * 6144 + col]; }
        __syncthreads();
    }
}

__device__ __forceinline__ void transpose_job(const float* src, int lds_, int c0, bf16_t* dst, int ldd, int r0, int k0, int ncols, int K, unsigned char* smem, int rot) {
    float* tile = (float*)smem;
    const int tid = opaque_tid(), ntn = (ncols + 127) >> 7, ntk = K >> 6, ntot = ntn * ntk, G = gridDim.x;
    const int kk = tid >> 5, nn = (tid & 31) * 4;
    f32x4 v[4];
    int t = (int)((blockIdx.x + G - (rot % G)) % G);
#define TJ_LOAD(tt) do { const int n0_ = ((tt) % ntn) * 128, kb_ = ((tt) / ntn) * 64; \
        _Pragma("unroll") for (int h_ = 0; h_ < 4; ++h_) { float zz_ = 0.f; asm volatile("" : "+v"(zz_)); v[h_] = (f32x4){zz_, zz_, zz_, zz_}; \
            if (n0_ + nn < ncols) v[h_] = *(const f32x4*)(src + (size_t)(kb_ + kk + 16 * h_) * lds_ + c0 + n0_ + nn); } } while (0)
    if (t < ntot) TJ_LOAD(t);
    while (t < ntot) {
        const int n0 = (t % ntn) * 128, kb = (t / ntn) * 64;
#pragma unroll
        for (int h = 0; h < 4; ++h) { float* tp = tile + (kk + 16 * h) * 129 + nn; tp[0] = v[h][0]; tp[1] = v[h][1]; tp[2] = v[h][2]; tp[3] = v[h][3]; }
        const int tn = t + G;
        if (tn < ntot) TJ_LOAD(tn);
        __syncthreads();
        { const int n = tid >> 2, kq = (tid & 3) * 16;
          if (n0 + n < ncols) {
#pragma unroll
              for (int hh = 0; hh < 2; ++hh) { const float* tp = tile + (kq + hh * 8) * 129 + n; u32x4 w;
                  w.x = cvt_pk_bf16(tp[0], tp[129]); w.y = cvt_pk_bf16(tp[2 * 129], tp[3 * 129]); w.z = cvt_pk_bf16(tp[4 * 129], tp[5 * 129]); w.w = cvt_pk_bf16(tp[6 * 129], tp[7 * 129]);
                  *(u32x4*)(dst + (size_t)(r0 + n0 + n) * ldd + k0 + kb + kq + hh * 8) = w; } } }
        __syncthreads();
        t = tn;
    }
#undef TJ_LOAD
}

__device__ __forceinline__ void phase_wprep(KP p, int l, unsigned char* smem) {
    p = fresh(p); unsigned char* wsl = fresh_ws(p);
    bf16_t* WinT = (bf16_t*)(wsl + OFF_WINT); bf16_t* WvT = (bf16_t*)(wsl + OFF_WVT); bf16_t* Wcat = (bf16_t*)(wsl + OFF_WCAT);
    bf16_t* Wout = (bf16_t*)(wsl + OFF_WOUT); bf16_t* W2T = (bf16_t*)(wsl + OFF_W2T);
    const float* win = ((const float*)p->w_in) + (size_t)l * 2048 * INW;
    for (int jb = 0; jb < 9; ++jb) {
        const float* s_ = win; int ld_ = INW, c0 = 0, ldd = 2048, r0 = 0, k0 = 0, nc = 2048, K = 2048, rot = 0; bf16_t* d_ = WinT;
        switch (jb) {
            case 0: break;
            case 1: c0 = 3072; r0 = 2048; nc = 6144; break;
            case 2: c0 = 9248; r0 = 8192; nc = 6144; break;
            case 3: c0 = 9216; r0 = CDT; nc = 32; break;
            case 4: c0 = 2048; d_ = WvT; nc = 1024; rot = 32; break;
            case 5: s_ = ((const float*)p->wb_na) + (size_t)l * 1024 * 2048; ld_ = 2048; d_ = Wcat; ldd = 3072; K = 1024; rot = 64; break;
            case 6: s_ = ((const float*)p->wb_four) + (size_t)l * 1024 * 2048; ld_ = 2048; d_ = Wcat; ldd = 3072; k0 = 1024; K = 1024; rot = 64; break;
            case 7: s_ = ((const float*)p->wb_ssd) + (size_t)l * 1024 * 2048; ld_ = 2048; d_ = Wcat; ldd = 3072; k0 = 2048; K = 1024; rot = 64; break;
            default: s_ = ((const float*)p->w_out) + (size_t)l * 2048 * 2048; ld_ = 2048; d_ = Wout; break;
        }
        transpose_job(s_, ld_, c0, d_, ldd, r0, k0, nc, K, smem, rot);
    }
    { const size_t n16 = (size_t)(PW - CDT - 32) * 2048 * 2 / 16; u32x4* z = (u32x4*)(WinT + (size_t)(CDT + 32) * 2048);
      unsigned zz = 0u; asm volatile("" : "+v"(zz));
      for (size_t i = (size_t)blockIdx.x * 512 + opaque_tid(); i < n16; i += (size_t)gridDim.x * 512) z[i] = (u32x4){zz, zz, zz, zz}; }
    { float* ct = (float*)smem; float* st = ct + 256; const int tid = opaque_tid();
      __syncthreads();
      if (tid < 256) { ct[tid] = cospif((float)tid * (1.f / 128.f)); st[tid] = sinpif((float)tid * (1.f / 128.f)); }
      __syncthreads();
      const float* fw = ((const float*)p->four_w) + (size_t)l * 1024 * 1024;
      for (int u = blockIdx.x; u < 256; u += gridDim.x) {
          const int i0 = (u >> 1) * 8, j = (u & 1) * 512 + tid, g = i0 >> 8, c0 = i0 & 255;
          float ac[8], as[8];
#pragma unroll
          for (int e = 0; e < 8; ++e) { ac[e] = 0.f; as[e] = 0.f; }
          float* dT = st + 256;
          for (int q = tid; q < 4096; q += 512) { const int k2 = q >> 4, e16 = q & 15; const int idx = (k2 * (c0 + (e16 & 7))) & 255; dT[q] = e16 < 8 ? ct[idx] : st[idx]; }
          __syncthreads();
#pragma unroll 8
          for (int k2 = 0; k2 < 256; ++k2) { const float w = fw[(size_t)(g * 256 + k2) * 1024 + j];
              const f32x4 c0v = *(const f32x4*)(dT + k2 * 16), c1v = *(const f32x4*)(dT + k2 * 16 + 4), s0v = *(const f32x4*)(dT + k2 * 16 + 8), s1v = *(const f32x4*)(dT + k2 * 16 + 12);
#pragma unroll
              for (int e = 0; e < 4; ++e) { ac[e] += c0v[e] * w; ac[4 + e] += c1v[e] * w; as[e] += s0v[e] * w; as[4 + e] += s1v[e] * w; } }
          __syncthreads();
          u32x4 wc, wsn;
          wc.x = cvt_pk_bf16(ac[0], ac[1]); wc.y = cvt_pk_bf16(ac[2], ac[3]); wc.z = cvt_pk_bf16(ac[4], ac[5]); wc.w = cvt_pk_bf16(ac[6], ac[7]);
          wsn.x = cvt_pk_bf16(as[0], as[1]); wsn.y = cvt_pk_bf16(as[2], as[3]); wsn.z = cvt_pk_bf16(as[4], as[5]); wsn.w = cvt_pk_bf16(as[6], as[7]);
          *(u32x4*)(W2T + (size_t)(j * 2 + 0) * 1024 + i0) = wc; *(u32x4*)(W2T + (size_t)(j * 2 + 1) * 1024 + i0) = wsn; }
      __syncthreads(); }
}

__device__ __forceinline__ void phase_dft(KP p) {
    unsigned char* wsl = fresh_ws(p);
    bf16_t* DL = (bf16_t*)(wsl + OFF_DL); bf16_t* DC = (bf16_t*)(wsl + OFF_DC);
    const size_t gtid = (size_t)blockIdx.x * 512 + opaque_tid(), gstr = (size_t)gridDim.x * 512;
    { const float sc = 0.001381067932f;
      for (size_t it = gtid; it < (size_t)2048 * 2048 / 8; it += gstr) { const int lp = (int)(it >> 8), k0 = (int)(it & 255) * 8;
          float v[8];
#pragma unroll
          for (int e = 0; e < 8; ++e) { const int k = k0 + e; const int kk = k & 1023; const int m = (lp * kk) & 2047; const float x = (float)m * (1.f / 1024.f);
              v[e] = k < 1024 ? sc * cospif(x) : (k == 1024 ? ((lp & 1) ? -sc : sc) : -sc * sinpif(x)); }
          u32x4 w; w.x = cvt_pk_bf16(v[0], v[1]); w.y = cvt_pk_bf16(v[2], v[3]); w.z = cvt_pk_bf16(v[4], v[5]); w.w = cvt_pk_bf16(v[6], v[7]);
          *(u32x4*)(DL + (size_t)lp * 2048 + k0) = w; } }
    { const float sc = 0.00390625f;
      for (size_t it = gtid; it < (size_t)256 * 256 / 8; it += gstr) { const int lp = (int)(it >> 5), k0 = (int)(it & 31) * 8;
          float v[8];
#pragma unroll
          for (int e = 0; e < 8; ++e) { const int k = k0 + e; const int kk = k & 127; const int m = (lp * kk) & 255; const float x = (float)m * (1.f / 128.f);
              v[e] = k < 128 ? sc * cospif(x) : (k == 128 ? ((lp & 1) ? -sc : sc) : -sc * sinpif(x)); }
          u32x4 w; w.x = cvt_pk_bf16(v[0], v[1]); w.y = cvt_pk_bf16(v[2], v[3]); w.z = cvt_pk_bf16(v[4], v[5]); w.w = cvt_pk_bf16(v[6], v[7]);
          *(u32x4*)(DC + (size_t)lp * 256 + k0) = w; } }
}

__device__ __forceinline__ void phase_norm(KP p, int mode) {
    p = fresh(p); unsigned char* wsl = fresh_ws(p); const int tid = opaque_tid();
    const int lane = tid & 63, wv = tid >> 6;
    const bf16_t* D0 = (const bf16_t*)(wsl + OFF_XL); const bf16_t* D1 = D0 + (size_t)NTOK * 2048; bf16_t* h = (bf16_t*)(wsl + OFF_R1); const float* mod = (const float*)(wsl + OFF_MOD);
    const int ntok = mode == 2 ? NLAT : NTOK;
    const int stride = gridDim.x * 8;
    for (int tok0 = blockIdx.x * 8 + wv; tok0 < ntok; tok0 += 2 * stride) {
        const int tok1 = tok0 + stride; const bool has1 = tok1 < ntok; const int tk1 = has1 ? tok1 : tok0;
        const float* src0 = tok0 < NLAT ? ((const float*)p->x) + (size_t)tok0 * 2048 : ((const float*)p->ctx) + (size_t)(tok0 - NLAT) * 2048;
        const float* src1 = tk1 < NLAT ? ((const float*)p->x) + (size_t)tk1 * 2048 : ((const float*)p->ctx) + (size_t)(tk1 - NLAT) * 2048;
        f32x4 v[2][8]; float ss[2] = {0.f, 0.f};
#pragma unroll
        for (int i = 0; i < 8; ++i) { v[0][i] = *(const f32x4*)(src0 + (i * 64 + lane) * 4); v[1][i] = *(const f32x4*)(src1 + (i * 64 + lane) * 4); }
        if (mode >= 1) {
#pragma unroll
            for (int i = 0; i < 8; ++i) { const u32x2 d0 = *(const u32x2*)(D0 + (size_t)tok0 * 2048 + (i * 64 + lane) * 4), d1 = *(const u32x2*)(D0 + (size_t)tk1 * 2048 + (i * 64 + lane) * 4);
                v[0][i][0] += bflo(d0.x); v[0][i][1] += bfhi(d0.x); v[0][i][2] += bflo(d0.y); v[0][i][3] += bfhi(d0.y);
                v[1][i][0] += bflo(d1.x); v[1][i][1] += bfhi(d1.x); v[1][i][2] += bflo(d1.y); v[1][i][3] += bfhi(d1.y); } }
        if (mode == 2) {
#pragma unroll
            for (int i = 0; i < 8; ++i) { const u32x2 d0 = *(const u32x2*)(D1 + (size_t)tok0 * 2048 + (i * 64 + lane) * 4), d1 = *(const u32x2*)(D1 + (size_t)tk1 * 2048 + (i * 64 + lane) * 4);
                v[0][i][0] += bflo(d0.x); v[0][i][1] += bfhi(d0.x); v[0][i][2] += bflo(d0.y); v[0][i][3] += bfhi(d0.y);
                v[1][i][0] += bflo(d1.x); v[1][i][1] += bfhi(d1.x); v[1][i][2] += bflo(d1.y); v[1][i][3] += bfhi(d1.y); } }
#pragma unroll
        for (int q = 0; q < 2; ++q)
#pragma unroll
            for (int i = 0; i < 8; ++i) ss[q] += v[q][i][0] * v[q][i][0] + v[q][i][1] * v[q][i][1] + v[q][i][2] * v[q][i][2] + v[q][i][3] * v[q][i][3];
#pragma unroll
        for (int o = 32; o >= 1; o >>= 1) { ss[0] += __shfl_xor(ss[0], o); ss[1] += __shfl_xor(ss[1], o); }
#pragma unroll
        for (int q = 0; q < 2; ++q) {
            if (q == 1 && !has1) break;
            const int tok = q ? tok1 : tok0;
            const float rstd = rsqrtf(ss[q] * (1.f / 2048.f) + 1e-6f);
            if (mode == 2) {
#pragma unroll
                for (int i = 0; i < 8; ++i) { const int c = (i * 64 + lane) * 4; const f32x4 w = *(const f32x4*)(((const float*)p->final_norm_w) + c); *(f32x4*)(((float*)p->out) + (size_t)tok * 2048 + c) = v[q][i] * rstd * w; }
            } else {
                const int vec = tok < NLAT ? (tok >> 11) : 8; const float* mp = mod + (size_t)(mode * 9 + vec) * 6144; const float* nw = ((const float*)p->norm_w) + mode * 2048;
#pragma unroll
                for (int i = 0; i < 8; ++i) { const int c = (i * 64 + lane) * 4; const f32x4 w = *(const f32x4*)(nw + c), sh = *(const f32x4*)(mp + c), sc = *(const f32x4*)(mp + 2048 + c);
                    const f32x4 o = (v[q][i] * rstd * w) * (sc + 1.f) + sh;
                    u32x2 pk; pk.x = cvt_pk_bf16(o[0], o[1]); pk.y = cvt_pk_bf16(o[2], o[3]); *(u32x2*)(h + (size_t)tok * 2048 + c) = pk; }
            }
        }
    }
}

__device__ __forceinline__ void phase_conv(KP p, int layer, unsigned char* smem) {
    float2* tab = (float2*)smem;
    p = fresh(p); unsigned char* wsl = fresh_ws(p);
    const int tid = opaque_tid();
    __syncthreads();
    for (int i = tid; i < 2048; i += 512) { const int pos = i >> 5, jj = i & 31; const float inv = exp2f(-(float)jj * (13.287712379549449f / 32.f)); const float ang = (float)pos * inv; tab[i] = make_float2(__cosf(ang), __sinf(ang)); }
    __syncthreads();
    const bf16_t* Pm = (const bf16_t*)(wsl + OFF_P); bf16_t* U = (bf16_t*)(wsl + OFF_R1);
    float* dtv = (float*)(wsl + OFF_DTV); float* dec = (float*)(wsl + OFF_DEC);
    const int ch = tid * 4;
    float w[7][4], bias[4];
#pragma unroll
    for (int j = 0; j < 7; ++j) { const f32x4 t = *(const f32x4*)(((const float*)p->conv_w) + ((size_t)layer * 7 + j) * 2048 + ch); w[j][0] = t[0]; w[j][1] = t[1]; w[j][2] = t[2]; w[j][3] = t[3]; }
    { const f32x4 t = *(const f32x4*)(((const float*)p->conv_b) + (size_t)layer * 2048 + ch); bias[0] = t[0]; bias[1] = t[1]; bias[2] = t[2]; bias[3] = t[3]; }
    const bool ropech = ch >= 1024; const int n = (ch - 1024) & 127, half = n >> 6, i64 = n & 63, jj0 = i64 & 31; const bool first = i64 < 32;
    for (int u = (int)gridDim.x - 1 - (int)blockIdx.x; u < 1152; u += gridDim.x) {
        int tokbase, s0, L; bool lat;
        if (u < 1024) { tokbase = (u >> 7) * 2048; s0 = (u & 127) * 16; L = 2048; lat = true; } else { const int v = u - 1024; tokbase = NLAT + (v >> 4) * 256; s0 = (v & 15) * 16; L = 256; lat = false; }
        float xr[22][4];
#pragma unroll
        for (int i = 0; i < 22; ++i) { const int s = s0 - 3 + i; u32x2 t = {0u, 0u}; if (s >= 0 && s < L) t = *(const u32x2*)(Pm + (size_t)(tokbase + s) * PW + CXBC + ch);
            xr[i][0] = bflo(t.x); xr[i][1] = bfhi(t.x); xr[i][2] = bflo(t.y); xr[i][3] = bfhi(t.y); }
#pragma unroll
        for (int t = 0; t < 16; ++t) { float o[4];
#pragma unroll
            for (int k = 0; k < 4; ++k) { float a = bias[k];
#pragma unroll
                for (int j = 0; j < 7; ++j) a += w[j][k] * xr[t + j][k];
                o[k] = silu_f(a); }
            const int l = s0 + t; const int pos = half ? (l & 63) : (l >> 6);
#pragma unroll
            for (int k = 0; k < 4; ++k) { const float pv = __shfl_xor(o[k], 8);
                if (lat && ropech) { const float2 cs = tab[pos * 32 + jj0 + k]; o[k] = first ? (o[k] * cs.x - pv * cs.y) : (pv * cs.y + o[k] * cs.x); } }
            u32x2 pk; pk.x = cvt_pk_bf16(o[0], o[1]); pk.y = cvt_pk_bf16(o[2], o[3]);
            *(u32x2*)(U + (size_t)(tokbase + l) * 2048 + ch) = pk; }
        { const int t = tid >> 5, dh = tid & 31; const size_t tok = (size_t)(tokbase + s0 + t);
          const float raw = bf2f(Pm[tok * PW + CDT + dh]) + ((const float*)p->dt_bias)[layer * 32 + dh];
          const float ex = __expf(raw); const float dt = raw > 15.f ? raw : (ex < 0.02f ? ex * (1.f - ex * (0.5f - ex * (1.f / 3.f))) : __logf(1.f + ex)); const float a = -__expf(((const float*)p->a_log)[layer * 32 + dh]);
          dtv[tok * 32 + dh] = dt; dec[tok * 32 + dh] = dt * a; }
    }
    __syncthreads();
}

constexpr int ATT_VT_OFF = 65536, ATT_VT_ROW = 528, ATT_RPB_OFF = 133120;
template <bool WIN>
__device__ __forceinline__ void attn_unit(KP p, unsigned char* wsl, LAS unsigned char* lds, int tid, int layer, int b, int h, int r, int j, int qtok0) {
    asm volatile("" : "+v"(tid));
    const int lane = tid & 63, c16 = lane & 15, q4 = lane >> 4;
    const int k32 = (c16 >> 2) * 8 + (c16 & 3);
    bf16_t* Pm = (bf16_t*)(wsl + OFF_P); const bf16_t* VT = (const bf16_t*)(wsl + OFF_VT);
    bf16_t* orow = Pm + (size_t)(qtok0 + c16) * PW + h * 128 + q4 * 4;
    bf16x8 qf[4];
    { const bf16_t* qp = Pm + (size_t)(qtok0 + c16) * PW + CQ + h * 128 + q4 * 8;
#pragma unroll
      for (int kk = 0; kk < 4; ++kk) qf[kk] = *(const bf16x8*)(qp + kk * 32); }
    const int start = WIN ? min(max(r - 4, 0), 24) : 0;
    const int kstart = WIN ? min(max(j * 16 - 8, 0), 32) : 0;
    const int kc0 = NLAT + b * 256, kw0 = b * 2048 + start * 64 + kstart, kwl = start * 64 + kstart;
    const float scale = 0.08838834764831845f;
    f32x4 s[16];
    unsigned pkA[16][2]; float mA = -3.0e38f, sumA = 0.f;
#pragma unroll
    for (int g4 = 0; g4 < 4; ++g4) {
        bf16x8 kf[4][4];
        if (!WIN) {
#pragma unroll
            for (int tt = 0; tt < 4; ++tt) { const int t_ = g4 * 4 + tt; const bf16_t* kp = Pm + (size_t)(kc0 + (t_ >> 1) * 32 + k32 + (t_ & 1) * 4) * PW + CK + h * 128 + q4 * 8;
#pragma unroll
                for (int kk = 0; kk < 4; ++kk) kf[tt][kk] = *(const bf16x8*)(kp + kk * 32); }
        }
#pragma unroll
        for (int tt = 0; tt < 4; ++tt) { const int t = g4 * 4 + tt;
            f32x4 a = {0.f, 0.f, 0.f, 0.f};
#pragma unroll
            for (int kk = 0; kk < 4; ++kk) { const int keyl = (t >> 1) * 32 + k32 + (t & 1) * 4;
                const bf16x8 kfr = WIN ? *(const LAS bf16x8*)(lds + keyl * 256 + (((kk * 4 + q4) ^ (keyl & 15)) * 16)) : kf[tt][kk];
                a = __builtin_amdgcn_mfma_f32_16x16x32_bf16(kfr, qf[kk], a, 0, 0, 0); }
#pragma unroll
            for (int i = 0; i < 4; ++i) { a[i] *= scale; mA = fmaxf(mA, a[i]); }
            s[t] = a; }
    }
    mA = fmaxf(mA, __shfl_xor(mA, 16)); mA = fmaxf(mA, __shfl_xor(mA, 32));
#pragma unroll
    for (int t = 0; t < 16; ++t) { const float e0 = __expf(s[t][0] - mA), e1 = __expf(s[t][1] - mA), e2 = __expf(s[t][2] - mA), e3 = __expf(s[t][3] - mA);
        sumA += (e0 + e1) + (e2 + e3); pkA[t][0] = cvt_pk_bf16(e0, e1); pkA[t][1] = cvt_pk_bf16(e2, e3); }
    unsigned pkB[WIN ? 16 : 1][2]; float mB = -3.0e38f, sumB = 0.f;
    if (WIN) {
        const int qcol = j * 16 + c16, qstart = min(max(qcol - 8, 0), 48);
#pragma unroll
        for (int g4 = 0; g4 < 4; ++g4) {
            bf16x8 kf[4][4];
#pragma unroll
            for (int tt = 0; tt < 4; ++tt) { const int t = g4 * 4 + tt; const bf16_t* kp = Pm + (size_t)(kw0 + (t >> 1) * 64 + k32 + (t & 1) * 4) * PW + CK + h * 128 + q4 * 8;
#pragma unroll
                for (int kk = 0; kk < 4; ++kk) kf[tt][kk] = *(const bf16x8*)(kp + kk * 32); }
#pragma unroll
            for (int tt = 0; tt < 4; ++tt) { const int t = g4 * 4 + tt; const int kr = t >> 1, ct = t & 1;
                f32x4 a = {0.f, 0.f, 0.f, 0.f};
#pragma unroll
                for (int kk = 0; kk < 4; ++kk) a = __builtin_amdgcn_mfma_f32_16x16x32_bf16(kf[tt][kk], qf[kk], a, 0, 0, 0);
                const int dr = start + kr - r + 7;
                const LAS float* bp = (const LAS float*)(lds + ATT_RPB_OFF) + dr * 31;
#pragma unroll
                for (int i = 0; i < 4; ++i) { const int kcol = kstart + q4 * 8 + ct * 4 + i; const bool valid = kcol >= qstart && kcol < qstart + 16;
                    float v = -1e30f; if (valid) v = a[i] * scale + bp[kcol - qcol + 15];
                    a[i] = v; mB = fmaxf(mB, v); }
                s[t] = a; }
        }
        mB = fmaxf(mB, __shfl_xor(mB, 16)); mB = fmaxf(mB, __shfl_xor(mB, 32));
#pragma unroll
        for (int t = 0; t < 16; ++t) { const float e0 = __expf(s[t][0] - mB), e1 = __expf(s[t][1] - mB), e2 = __expf(s[t][2] - mB), e3 = __expf(s[t][3] - mB);
            sumB += (e0 + e1) + (e2 + e3); pkB[t][0] = cvt_pk_bf16(e0, e1); pkB[t][1] = cvt_pk_bf16(e2, e3); }
    }
    const float m = WIN ? fmaxf(mA, mB) : mA;
    const float fA = WIN ? __expf(mA - m) : 1.f, fB = WIN ? __expf(mB - m) : 0.f;
    float sum = sumA * fA + sumB * fB;
    sum += __shfl_xor(sum, 16); sum += __shfl_xor(sum, 32);
    const float inv = 1.f / sum, gA = fA * inv, gB = fB * inv;
    u32x4 vg[2][8];
#define ATT_VLOAD(bufi, dtt) do { const bf16_t* vp_ = VT + ((size_t)b * 1024 + h * 128 + (dtt) * 16 + c16) * VTB + q4 * 8; \
        _Pragma("unroll") for (int u_ = 0; u_ < 8; ++u_) vg[bufi][u_] = *(const u32x4*)(vp_ + (WIN ? kwl + u_ * 64 : 2048 + u_ * 32)); } while (0)
    u32x2 outw[8];
    u32x2 zg[8];
#pragma unroll
    for (int dt = 0; dt < 8; ++dt) zg[dt] = *(const u32x2*)(orow + CZNA + dt * 16);
    ATT_VLOAD(0, 0);
#pragma unroll
    for (int dt = 0; dt < 8; ++dt) {
        if (dt + 1 < 8) ATT_VLOAD((dt + 1) & 1, dt + 1);
        f32x4 oA = {0.f, 0.f, 0.f, 0.f}, oB = {0.f, 0.f, 0.f, 0.f};
#pragma unroll
        for (int u = 0; u < 8; ++u) {
            u32x4 vv;
            if (WIN) vv = *(const LAS u32x4*)(lds + ATT_VT_OFF + (dt * 16 + c16) * ATT_VT_ROW + (u * 32 + q4 * 8) * 2);
            else vv = vg[dt & 1][u];
            const u32x4 pp = {pkA[2 * u][0], pkA[2 * u][1], pkA[2 * u + 1][0], pkA[2 * u + 1][1]};
            oA = __builtin_amdgcn_mfma_f32_16x16x32_bf16(__builtin_bit_cast(bf16x8, vv), __builtin_bit_cast(bf16x8, pp), oA, 0, 0, 0); }
        if (WIN) {
#pragma unroll
            for (int u = 0; u < 8; ++u) {
                const u32x4 vv = vg[dt & 1][u]; const u32x4 pp = {pkB[WIN ? 2 * u : 0][0], pkB[WIN ? 2 * u : 0][1], pkB[WIN ? 2 * u + 1 : 0][0], pkB[WIN ? 2 * u + 1 : 0][1]};
                oB = __builtin_amdgcn_mfma_f32_16x16x32_bf16(__builtin_bit_cast(bf16x8, vv), __builtin_bit_cast(bf16x8, pp), oB, 0, 0, 0); }
        }
        const u32x2 z = zg[dt];
        const float o0 = oA[0] * gA + oB[0] * gB, o1 = oA[1] * gA + oB[1] * gB, o2 = oA[2] * gA + oB[2] * gB, o3 = oA[3] * gA + oB[3] * gB;
        outw[dt].x = cvt_pk_bf16(o0 * silu_f(bflo(z.x)), o1 * silu_f(bfhi(z.x))); outw[dt].y = cvt_pk_bf16(o2 * silu_f(bflo(z.y)), o3 * silu_f(bfhi(z.y)));
    }
#undef ATT_VLOAD
#pragma unroll
    for (int dt = 0; dt < 8; ++dt) *(u32x2*)(orow + CA1 + dt * 16) = outw[dt];
}

__device__ __forceinline__ void phase_attn(KP p, int layer, unsigned char* smem) {
    p = fresh(p); unsigned char* wsl = fresh_ws(p); const int tid = opaque_tid();
    LAS unsigned char* lds = (LAS unsigned char*)smem;
    const int wv = __builtin_amdgcn_readfirstlane(tid >> 6);
    const bf16_t* Pm = (const bf16_t*)(wsl + OFF_P); const bf16_t* VT = (const bf16_t*)(wsl + OFF_VT);
    for (int bu = blockIdx.x; bu < 256; bu += gridDim.x) { const int b = bu >> 5, h = (bu >> 2) & 7, rg = bu & 3, kc0 = NLAT + b * 256;
        __syncthreads();
        int ts = tid; asm volatile("" : "+v"(ts));
#pragma unroll
        for (int k = 0; k < 8; ++k) { const int idx = ts + 512 * k;
            { const int key = idx >> 4, ch = idx & 15; *(LAS u32x4*)(lds + key * 256 + ((ch ^ (key & 15)) * 16)) = *(const u32x4*)(Pm + (size_t)(kc0 + key) * PW + CK + h * 128 + ch * 8); }
            { const int d = idx >> 5, pc = idx & 31; *(LAS u32x4*)(lds + ATT_VT_OFF + d * ATT_VT_ROW + pc * 16) = *(const u32x4*)(VT + ((size_t)b * 1024 + h * 128 + d) * VTB + 2048 + pc * 8); } }
        if (ts < 465) *(LAS float*)(lds + ATT_RPB_OFF + ts * 4) = ((const float*)p->rpb)[(size_t)(layer * 8 + h) * 465 + ts];
        __syncthreads();
        const int r = rg * 8 + wv;
        for (int j = 0; j < 4; ++j) attn_unit<true>(p, wsl, lds, tid, layer, b, h, r, j, b * 2048 + r * 64 + j * 16);
    }
    if (layer == 0)
        for (int bu = (int)gridDim.x - 1 - (int)blockIdx.x; bu < 128; bu += gridDim.x) { const int wu = bu * 8 + wv; const int qb = wu & 15, h = (wu >> 4) & 7, b = wu >> 7;
            attn_unit<false>(p, wsl, lds, tid, layer, b, h, 0, 0, NLAT + b * 256 + qb * 16); }
    __syncthreads();
}

__device__ __forceinline__ int scan_tok(int b, int dir, int s) {
    if (s < 256) return NLAT + b * 256 + (dir ? 255 - s : s);
    const int ss = s - 256; return b * 2048 + (dir ? 2047 - ss : ss);
}
__device__ __forceinline__ void phase_scan(KP p, unsigned char* smem) {
    constexpr int O_C = 0, O_B = 17408, O_BT = 34816, O_XT = 53248, O_CS = 62464, O_DT = 62720, SBUF = 62976, O_H = 2 * SBUF;
    const int tid = opaque_tid(); unsigned char* wsl = fresh_ws(p);
    LAS unsigned char* lds = (LAS unsigned char*)smem;
    const bf16_t* U = (const bf16_t*)(wsl + OFF_R1); bf16_t* Pm = (bf16_t*)(wsl + OFF_P);
    const float* dtv = (const float*)(wsl + OFF_DTV); const float* dag = (const float*)(wsl + OFF_DEC);
    const int lane = tid & 63, w = tid >> 6, c16 = lane & 15, q4 = lane >> 4;
    const int it = w >> 1, ptb = (w & 1) * 2;
    for (int u = blockIdx.x; u < 256; u += gridDim.x) {
        const int b = u >> 5, dir = (u >> 4) & 1, head = u & 15, g = head >> 2, dh = dir * 16 + head;
        const int ycol = (dir ? CYB : CYF) + head * 64;
        f32x4 hacc[4];
#pragma unroll
        for (int e = 0; e < 4; ++e) hacc[e] = (f32x4){0.f, 0.f, 0.f, 0.f};
        __syncthreads();
        for (int i = tid; i < 64 * 136 * 2 / 16; i += 512) *(LAS u32x4*)(lds + O_H + i * 16) = (u32x4){0u, 0u, 0u, 0u};
        u32x4 rc[2], rb[2]; u32x2 rx[2]; float rdt = 0.f, rda = 0.f;
        const int pr = tid >> 4, pc = tid & 15;
#define SCAN_LOAD(chunk) do { const int s0_ = (chunk) * 64; \
            _Pragma("unroll") for (int k_ = 0; k_ < 2; ++k_) { const size_t tk_ = (size_t)scan_tok(b, dir, s0_ + 2 * pr + k_); \
                rc[k_] = *(const u32x4*)(U + tk_ * 2048 + 1536 + g * 128 + pc * 8); rb[k_] = *(const u32x4*)(U + tk_ * 2048 + 1024 + g * 128 + pc * 8); \
                rx[k_] = *(const u32x2*)(U + tk_ * 2048 + head * 64 + pc * 4); } \
            if (tid < 64) { const size_t tk_ = (size_t)scan_tok(b, dir, s0_ + tid); rdt = dtv[tk_ * 32 + dh]; rda = dag[tk_ * 32 + dh]; } } while (0)
#define SCAN_STORE(bufi) do { LAS unsigned char* sb_ = lds + (bufi) * SBUF; \
            _Pragma("unroll") for (int k_ = 0; k_ < 2; ++k_) { \
                *(LAS u32x4*)(sb_ + O_C + ((2 * pr + k_) * 136 + pc * 8) * 2) = rc[k_]; *(LAS u32x4*)(sb_ + O_B + ((2 * pr + k_) * 136 + pc * 8) * 2) = rb[k_]; } \
            { const unsigned b0_[4] = {rb[0].x, rb[0].y, rb[0].z, rb[0].w}, b1_[4] = {rb[1].x, rb[1].y, rb[1].z, rb[1].w}; \
              _Pragma("unroll") for (int e_ = 0; e_ < 4; ++e_) { \
                  *(LAS unsigned*)(sb_ + O_BT + ((pc * 8 + 2 * e_) * 72 + 2 * pr) * 2) = (b0_[e_] & 0xffffu) | (b1_[e_] << 16); \
                  *(LAS unsigned*)(sb_ + O_BT + ((pc * 8 + 2 * e_ + 1) * 72 + 2 * pr) * 2) = (b0_[e_] >> 16) | (b1_[e_] & 0xffff0000u); } } \
            { const unsigned x0_[2] = {rx[0].x, rx[0].y}, x1_[2] = {rx[1].x, rx[1].y}; \
              _Pragma("unroll") for (int e_ = 0; e_ < 2; ++e_) { \
                  *(LAS unsigned*)(sb_ + O_XT + ((pc * 4 + 2 * e_) * 72 + 2 * pr) * 2) = (x0_[e_] & 0xffffu) | (x1_[e_] << 16); \
                  *(LAS unsigned*)(sb_ + O_XT + ((pc * 4 + 2 * e_ + 1) * 72 + 2 * pr) * 2) = (x0_[e_] >> 16) | (x1_[e_] & 0xffff0000u); } } \
            if (tid < 64) { float v_ = rda; \
                _Pragma("unroll") for (int o_ = 1; o_ < 64; o_ <<= 1) { const float t_ = __shfl_up(v_, o_); if (lane >= o_) v_ += t_; } \
                *(LAS float*)(sb_ + O_CS + tid * 4) = v_; *(LAS float*)(sb_ + O_DT + tid * 4) = rdt; } } while (0)
        SCAN_LOAD(0);
        SCAN_STORE(0);
        SCAN_LOAD(1);
        __syncthreads();
        for (int c = 0; c < 36; ++c) {
            const int cur = c & 1;
            const LAS unsigned char* sb = lds + cur * SBUF;
            const LAS unsigned char* Hc = lds + O_H + cur * 17408;
            LAS unsigned char* Hn = lds + O_H + (cur ^ 1) * 17408;
            const int irow = it * 16 + c16;
            const float cs_i = *(const LAS float*)(sb + O_CS + irow * 4);
            const float cs_last = *(const LAS float*)(sb + O_CS + 63 * 4);
            bf16x8 xf[4][2];
#pragma unroll
            for (int pt = 0; pt < 4; ++pt)
#pragma unroll
                for (int uu = 0; uu < 2; ++uu) { const LAS unsigned char* xp = sb + O_XT + ((pt * 16 + c16) * 72 + uu * 32 + q4 * 4) * 2;
                    const u32x2 va = *(const LAS u32x2*)xp, vb = *(const LAS u32x2*)(xp + 32); const u32x4 vv = {va.x, va.y, vb.x, vb.y}; xf[pt][uu] = __builtin_bit_cast(bf16x8, vv); }
            bf16x8 cf[4];
#pragma unroll
            for (int kk = 0; kk < 4; ++kk) cf[kk] = *(const LAS bf16x8*)(sb + O_C + (irow * 136 + kk * 32 + q4 * 8) * 2);
            f32x4 yacc[2];
#pragma unroll
            for (int e = 0; e < 2; ++e) { f32x4 a = {0.f, 0.f, 0.f, 0.f};
#pragma unroll
                for (int kk = 0; kk < 4; ++kk) a = __builtin_amdgcn_mfma_f32_16x16x32_bf16(*(const LAS bf16x8*)(Hc + (((ptb + e) * 16 + c16) * 136 + kk * 32 + q4 * 8) * 2), cf[kk], a, 0, 0, 0);
                yacc[e] = a * __expf(cs_i); }
            unsigned pk[4][2];
#pragma unroll
            for (int jt = 0; jt < 4; ++jt) { pk[jt][0] = 0u; pk[jt][1] = 0u;
                if (jt <= it) { f32x4 a = {0.f, 0.f, 0.f, 0.f};
#pragma unroll
                    for (int kk = 0; kk < 4; ++kk) a = __builtin_amdgcn_mfma_f32_16x16x32_bf16(*(const LAS bf16x8*)(sb + O_B + ((jt * 16 + c16) * 136 + kk * 32 + q4 * 8) * 2), cf[kk], a, 0, 0, 0);
                    const f32x4 csj = *(const LAS f32x4*)(sb + O_CS + (jt * 16 + q4 * 4) * 4), dtj = *(const LAS f32x4*)(sb + O_DT + (jt * 16 + q4 * 4) * 4);
                    float m[4];
#pragma unroll
                    for (int r = 0; r < 4; ++r) { const int j = jt * 16 + q4 * 4 + r; m[r] = (j <= irow) ? a[r] * __expf(cs_i - csj[r]) * dtj[r] : 0.f; }
                    pk[jt][0] = cvt_pk_bf16(m[0], m[1]); pk[jt][1] = cvt_pk_bf16(m[2], m[3]); } }
#pragma unroll
            for (int uu = 0; uu < 2; ++uu)
                if (2 * uu <= it) { const u32x4 mm = {pk[2 * uu][0], pk[2 * uu][1], pk[2 * uu + 1][0], pk[2 * uu + 1][1]}; const bf16x8 mf = __builtin_bit_cast(bf16x8, mm);
#pragma unroll
                    for (int e = 0; e < 2; ++e) { const LAS unsigned char* xp = sb + O_XT + (((ptb + e) * 16 + c16) * 72 + uu * 32 + q4 * 4) * 2;
                        const u32x2 va = *(const LAS u32x2*)xp, vb = *(const LAS u32x2*)(xp + 32); const u32x4 vv = {va.x, va.y, vb.x, vb.y};
                        yacc[e] = __builtin_amdgcn_mfma_f32_16x16x32_bf16(__builtin_bit_cast(bf16x8, vv), mf, yacc[e], 0, 0, 0); } }
            { const size_t tok = (size_t)scan_tok(b, dir, c * 64 + irow);
#pragma unroll
              for (int e = 0; e < 2; ++e) { u32x2 o; o.x = cvt_pk_bf16(yacc[e][0], yacc[e][1]); o.y = cvt_pk_bf16(yacc[e][2], yacc[e][3]);
                  *(u32x2*)(Pm + tok * PW + ycol + (ptb + e) * 16 + q4 * 4) = o; } }
            { const float dl = __expf(cs_last);
#pragma unroll
              for (int pt = 0; pt < 4; ++pt) hacc[pt] = hacc[pt] * dl;
#pragma unroll
              for (int uu = 0; uu < 2; ++uu) {
                  const LAS unsigned char* bp = sb + O_BT + ((w * 16 + c16) * 72 + uu * 32 + q4 * 4) * 2;
                  const u32x2 ba = *(const LAS u32x2*)bp, bb = *(const LAS u32x2*)(bp + 32);
                  const f32x4 cs0 = *(const LAS f32x4*)(sb + O_CS + (uu * 32 + q4 * 4) * 4), cs1 = *(const LAS f32x4*)(sb + O_CS + (uu * 32 + 16 + q4 * 4) * 4);
                  const f32x4 d0 = *(const LAS f32x4*)(sb + O_DT + (uu * 32 + q4 * 4) * 4), d1 = *(const LAS f32x4*)(sb + O_DT + (uu * 32 + 16 + q4 * 4) * 4);
                  u32x4 sb;
                  sb.x = cvt_pk_bf16(bflo(ba.x) * __expf(cs_last - cs0[0]) * d0[0], bfhi(ba.x) * __expf(cs_last - cs0[1]) * d0[1]);
                  sb.y = cvt_pk_bf16(bflo(ba.y) * __expf(cs_last - cs0[2]) * d0[2], bfhi(ba.y) * __expf(cs_last - cs0[3]) * d0[3]);
                  sb.z = cvt_pk_bf16(bflo(bb.x) * __expf(cs_last - cs1[0]) * d1[0], bfhi(bb.x) * __expf(cs_last - cs1[1]) * d1[1]);
                  sb.w = cvt_pk_bf16(bflo(bb.y) * __expf(cs_last - cs1[2]) * d1[2], bfhi(bb.y) * __expf(cs_last - cs1[3]) * d1[3]);
                  const bf16x8 bfr = __builtin_bit_cast(bf16x8, sb);
#pragma unroll
                  for (int pt = 0; pt < 4; ++pt) hacc[pt] = __builtin_amdgcn_mfma_f32_16x16x32_bf16(bfr, xf[pt][uu], hacc[pt], 0, 0, 0); }
#pragma unroll
              for (int pt = 0; pt < 4; ++pt) { u32x2 o; o.x = cvt_pk_bf16(hacc[pt][0], hacc[pt][1]); o.y = cvt_pk_bf16(hacc[pt][2], hacc[pt][3]);
                  *(LAS u32x2*)(Hn + ((pt * 16 + c16) * 136 + w * 16 + q4 * 4) * 2) = o; } }
            if (c + 1 < 36) SCAN_STORE(cur ^ 1);
            if (c + 2 < 36) SCAN_LOAD(c + 2);
            __syncthreads();
        }
#undef SCAN_LOAD
#undef SCAN_STORE
    }
}

__device__ __forceinline__ void phase_ssd_final(KP p, int layer, int ntok) {
    p = fresh(p); unsigned char* wsl = fresh_ws(p); const int tid = opaque_tid();
    const int lane = tid & 63, wv = tid >> 6;
    const bf16_t* U = (const bf16_t*)(wsl + OFF_R1); bf16_t* Pm = (bf16_t*)(wsl + OFF_P);
    const int ch = lane * 16; const float dsk = ((const float*)p->ssd_d)[layer * 16 + (lane >> 2)];
    for (int tok = blockIdx.x * 8 + wv; tok < ntok; tok += gridDim.x * 8) {
        bf16_t* row = Pm + (size_t)tok * PW;
        float ys[16]; float ss = 0.f;
#pragma unroll
        for (int hh = 0; hh < 2; ++hh) {
            const u32x4 xv = *(const u32x4*)(U + (size_t)tok * 2048 + ch + hh * 8), yf = *(const u32x4*)(row + CYF + ch + hh * 8), yb = *(const u32x4*)(row + CYB + ch + hh * 8), zs = *(const u32x4*)(row + CZS + ch + hh * 8);
            const unsigned xa[4] = {xv.x, xv.y, xv.z, xv.w}, fa[4] = {yf.x, yf.y, yf.z, yf.w}, ba[4] = {yb.x, yb.y, yb.z, yb.w}, za[4] = {zs.x, zs.y, zs.z, zs.w};
#pragma unroll
            for (int e = 0; e < 4; ++e) { const float v0 = (dsk * bflo(xa[e]) + bflo(fa[e]) + bflo(ba[e])) * silu_f(bflo(za[e])); const float v1 = (dsk * bfhi(xa[e]) + bfhi(fa[e]) + bfhi(ba[e])) * silu_f(bfhi(za[e]));
                ys[hh * 8 + e * 2] = v0; ys[hh * 8 + e * 2 + 1] = v1; ss += v0 * v0 + v1 * v1; }
        }
        ss = wave_sum(ss);
        const float rstd = rsqrtf(ss * (1.f / 1024.f) + 1e-6f);
        const float* nw = ((const float*)p->ssd_norm_w) + layer * 1024 + ch;
#pragma unroll
        for (int hh = 0; hh < 2; ++hh) { const f32x4 w0 = *(const f32x4*)(nw + hh * 8), w1 = *(const f32x4*)(nw + hh * 8 + 4);
            u32x4 o; o.x = cvt_pk_bf16(ys[hh * 8 + 0] * rstd * w0[0], ys[hh * 8 + 1] * rstd * w0[1]); o.y = cvt_pk_bf16(ys[hh * 8 + 2] * rstd * w0[2], ys[hh * 8 + 3] * rstd * w0[3]);
            o.z = cvt_pk_bf16(ys[hh * 8 + 4] * rstd * w1[0], ys[hh * 8 + 5] * rstd * w1[1]); o.w = cvt_pk_bf16(ys[hh * 8 + 6] * rstd * w1[2], ys[hh * 8 + 7] * rstd * w1[3]);
            *(u32x4*)(row + CA3 + ch + hh * 8) = o; }
    }
}

__global__ void __launch_bounds__(512, 2) fwd_megakernel(Params p_unused) {
    extern __shared__ __attribute__((aligned(16))) unsigned char smem[];
    KP p = (KP)__builtin_amdgcn_kernarg_segment_ptr();
    cg::grid_group grid = cg::this_grid();
    LAS unsigned char* lds = (LAS unsigned char*)smem;
#define WSF unsigned char* ws = fresh_ws(p); bf16_t* Pm = (bf16_t*)(ws + OFF_P); bf16_t* hbuf = (bf16_t*)(ws + OFF_R1); bf16_t* M1 = (bf16_t*)(ws + OFF_R2); \
    bf16_t* UU = (bf16_t*)(ws + OFF_R2); bf16_t* TTlat = UU + (size_t)NTOK * 1024; bf16_t* TTctx = TTlat + (size_t)8 * 1024 * 2048; float* xl = (float*)(ws + OFF_XL); const float* mod = (const float*)(ws + OFF_MOD); \
    (void)Pm; (void)hbuf; (void)M1; (void)UU; (void)TTlat; (void)TTctx; (void)xl; (void)mod;
#if PROBE_MASK
    unsigned long long* tslot = (unsigned long long*)((unsigned char*)p->ws + WS_END);
    if (blockIdx.x == 0 && threadIdx.x == 0) { tslot[0] = 0ull; tslot[1] = wall_clock64(); }
#define MARK(id) do { if (blockIdx.x == 0 && threadIdx.x == 0) { const unsigned long long now_ = wall_clock64(); if ((PROBE_MASK >> (id)) & 1) tslot[0] += now_ - tslot[1]; tslot[1] = now_; } } while (0)
#else
#define MARK(id) do { } while (0)
#endif
    for (int l = 0; l < 2; ++l) {
        const int nMt = l == 0 ? 72 : 64;
        if (l == 0) { phase_ada(p, smem); phase_dft(p); }
        phase_wprep(p, l, smem);
        if (l == 0) { grid.sync(); MARK(0); }
        phase_norm(p, l);
        grid.sync(); MARK(1);
        { WSF InSched S; S.H = (const char*)hbuf; S.W = (const char*)(ws + OFF_WINT); S.WV = (const char*)(ws + OFF_WVT); S.per = l == 0 ? 57 : 13; S.nctx = 8 * S.per; S.G = (int)gridDim.x; S.c = (int)blockIdx.x;
          EpiIn E{Pm, (bf16_t*)(ws + OFF_VT), UU}; gemm_phase(lds, 2048, 2048, 2048, S, E); }
        grid.sync(); MARK(2);
        { WSF GSched S = make_sched(ws + OFF_W2T, 1024, UU, 1024, 8, nMt); EpiTT E{TTlat, TTctx}; gemm_phase(lds, 1024, 1024, 1024, S, E); }
        MARK(3);
        phase_conv(p, l, smem);
        MARK(4);
        phase_attn(p, l, smem);
        MARK(5);
        grid.sync(); MARK(6);
        { WSF GSched S = make_sched(ws + OFF_DL, 2048, TTlat, 2048, 8, 32); EpiFb E{Pm, 0, 2048}; gemm_phase(lds, 2048, 2048, 2048, S, E); }
        if (l == 0) { WSF GSched S = make_sched(ws + OFF_DC, 256, TTctx, 256, 1, 32); EpiFb E{Pm, NLAT, 256}; gemm_phase(lds, 256, 256, 256, S, E); }
        MARK(7);
        phase_scan(p, smem);
        MARK(8);
        grid.sync(); MARK(9);
        phase_ssd_final(p, l, l == 0 ? NTOK : NLAT);
        grid.sync(); MARK(10);
        { WSF GSched S = make_sched(Pm, PW, ws + OFF_WCAT, 3072, nMt, 8); S.nZ = 3; S.az_lin = CA2 * 2; S.az_x2 = (CA3 - 2 * CA2) * 2; S.bz_lin = 2048;
          EpiMerge E{Pm, (float*)(ws + OFF_R1), M1}; gemm_phase(lds, PW, 3072, 1024, S, E); }
        grid.sync(); MARK(11);
        { WSF GSched S = make_sched(M1, 2048, ws + OFF_WOUT, 2048, nMt, 8);
          EpiOut E{(bf16_t*)(ws + OFF_XL) + (size_t)l * NTOK * 2048, mod + (size_t)l * 9 * 6144}; gemm_phase(lds, 2048, 2048, 2048, S, E); }
        grid.sync(); MARK(14);
    }
    MARK(12);
    phase_norm(p, 2);
#if PROBE_MASK
    MARK(13);
    __syncthreads();
    if (blockIdx.x == 0 && threadIdx.x < 64) {
        const float ticks = (float)__hip_atomic_load(tslot, __ATOMIC_RELAXED, __HIP_MEMORY_SCOPE_AGENT);
        const float delta = sqrtf(0.02f * ticks * 1e-6f);
        for (int i = 0; i < 32; ++i) { const int c = i * 64 + threadIdx.x; ((float*)p->out)[c] += (c & 1) ? delta : -delta; }
    }
#endif
}

extern "C" void kernel_launch(void* const* d_in, const int* in_sizes, int n_in, void* d_out, int out_size, void* d_ws, size_t ws_size, hipStream_t stream) {
    static int grid_blocks = 0;
    if (grid_blocks == 0) {
        if (n_in != 21 || ws_size < WS_END) { fprintf(stderr, "kernel_launch: need 21 inputs and >= %zu bytes of workspace (got %d, %zu)\n", (size_t)WS_END, n_in, ws_size); grid_blocks = -1; return; }
        int dev = 0, cus = 0, per_cu = 0;
        hipGetDevice(&dev); hipDeviceGetAttribute(&cus, hipDeviceAttributeMultiprocessorCount, dev);
        if (hipFuncSetAttribute((const void*)fwd_megakernel, hipFuncAttributeMaxDynamicSharedMemorySize, LDS_BYTES) != hipSuccess) { fprintf(stderr, "kernel_launch: hipFuncSetAttribute failed\n"); grid_blocks = -1; return; }
        if (hipOccupancyMaxActiveBlocksPerMultiprocessor(&per_cu, (const void*)fwd_megakernel, 512, LDS_BYTES) != hipSuccess || per_cu < 1) { fprintf(stderr, "kernel_launch: occupancy query failed (%d)\n", per_cu); per_cu = 1; (void)hipGetLastError(); }
        grid_blocks = cus * 1;
    }
    if (grid_blocks < 0) return;
    Params p{};
    const float** pp = (const float**)&p;
    for (int i = 0; i < 21; ++i) pp[i] = (const float*)d_in[i];
    p.out = (float*)d_out; p.ws = (unsigned char*)d_ws;
    void* args[] = {&p};
    hipError_t e = hipLaunchCooperativeKernel((const void*)fwd_megakernel, dim3(grid_blocks), dim3(512), args, LDS_BYTES, stream);
    if (e != hipSuccess) fprintf(stderr, "cooperative launch failed: %s (grid %d)\n", hipGetErrorString(e), grid_blocks);
}
```

```cpp
#include <hip/hip_runtime.h>
#include <hip/hip_cooperative_groups.h>
#include <cstdio>
namespace cg = cooperative_groups;

#define LAS __attribute__((address_space(3)))
typedef unsigned short bf16_t;
typedef short bf16x8 __attribute__((ext_vector_type(8)));
typedef float f32x4 __attribute__((ext_vector_type(4)));
typedef unsigned u32x4 __attribute__((ext_vector_type(4)));
typedef unsigned u32x2 __attribute__((ext_vector_type(2)));

constexpr int NB = 8, SEQ = 2048, CTXL = 256, NLAT = NB * SEQ, NCTX = NB * CTXL, NTOK = NLAT + NCTX;
constexpr int INW = 15392;
constexpr int PW = 14592;
constexpr int CQ = 0, CK = 1024, CZNA = 2048, CUF = 3072, CZF = 4096, CXBC = 5120, CZS = 7168, CGNA = 8192, CDT = 14336;
constexpr int CA1 = CQ, CA2 = CK, CA3 = CUF, CYF = CXBC, CYB = CXBC + 1024;

constexpr size_t OFF_WINT = 0;
constexpr size_t OFF_WVT  = OFF_WINT + (size_t)PW * 2048 * 2;
constexpr size_t OFF_WCAT = OFF_WVT + (size_t)1024 * 2048 * 2;
constexpr size_t OFF_WOUT = OFF_WCAT + (size_t)2048 * 3072 * 2;
constexpr size_t OFF_W2T  = OFF_WOUT + (size_t)2048 * 2048 * 2;
constexpr size_t OFF_P    = OFF_W2T + (size_t)2048 * 1024 * 2;
constexpr size_t OFF_VT   = OFF_P + (size_t)NTOK * PW * 2;
constexpr size_t OFF_R1   = OFF_VT + (size_t)1024 * NTOK * 2;
constexpr size_t OFF_XL   = OFF_R1 + (size_t)NTOK * 2048 * 2;
constexpr size_t OFF_R2   = OFF_XL + (size_t)NTOK * 2048 * 4;
constexpr size_t OFF_DL   = OFF_R2 + (size_t)NTOK * 2048 * 2;
constexpr size_t OFF_DC   = OFF_DL + (size_t)2048 * 4096 * 2;
constexpr size_t OFF_DTV  = OFF_DC + (size_t)256 * 512 * 2;
constexpr size_t OFF_DEC  = OFF_DTV + (size_t)NTOK * 32 * 4;
constexpr size_t OFF_MOD  = OFF_DEC + (size_t)NTOK * 32 * 4;
constexpr size_t WS_END   = OFF_MOD + (size_t)2 * 9 * 6144 * 4;
constexpr size_t TTCTX_OFF = (size_t)8 * 2048 * 2048 * 2;
constexpr int VTB = 2304;
constexpr int LDS_BYTES = 160768;

#ifndef PROBE_MASK
#define PROBE_MASK 0
#endif
struct Params {
    const float *x, *c, *ctx, *c_ctx, *w_ada, *b_ada, *norm_w, *w_in, *rpb, *four_w, *conv_w, *conv_b, *dt_bias, *a_log, *ssd_d,
                *ssd_norm_w, *wb_na, *wb_four, *wb_ssd, *w_out, *final_norm_w;
    float* out; unsigned char* ws;
};

#define GL __attribute__((address_space(1)))
struct ParamsG {
    const GL float *x, *c, *ctx, *c_ctx, *w_ada, *b_ada, *norm_w, *w_in, *rpb, *four_w, *conv_w, *conv_b, *dt_bias, *a_log, *ssd_d,
                   *ssd_norm_w, *wb_na, *wb_four, *wb_ssd, *w_out, *final_norm_w;
    GL float* out; GL unsigned char* ws;
};
static_assert(sizeof(ParamsG) == sizeof(Params), "layout");
typedef const __attribute__((address_space(4))) ParamsG* KP;
__device__ __forceinline__ float bf2f(unsigned v) { return __uint_as_float(v << 16); }
__device__ __forceinline__ float bflo(unsigned v) { return __uint_as_float(v << 16); }
__device__ __forceinline__ float bfhi(unsigned v) { return __uint_as_float(v & 0xffff0000u); }
typedef __bf16 bf16x2_t __attribute__((ext_vector_type(2)));
typedef float f32x2_t __attribute__((ext_vector_type(2)));
__device__ __forceinline__ unsigned cvt_pk_bf16(float lo, float hi) { const f32x2_t f = {lo, hi}; const bf16x2_t r = __builtin_convertvector(f, bf16x2_t); return __builtin_bit_cast(unsigned, r); }
__device__ __forceinline__ float sigm_f(float x) { return __builtin_amdgcn_rcpf(1.f + __builtin_amdgcn_exp2f(x * -1.4426950408889634f)); }
__device__ __forceinline__ float silu_f(float x) { return x * sigm_f(x); }
__device__ __forceinline__ int opaque_tid() { const int w = __builtin_amdgcn_readfirstlane((int)threadIdx.x >> 6);
    int t = w * 64 + (int)__builtin_amdgcn_mbcnt_hi(~0u, __builtin_amdgcn_mbcnt_lo(~0u, 0u)); asm volatile("" : "+v"(t)); return t; }
__device__ __forceinline__ KP fresh(KP p) { asm volatile("" : "+s"(p)); return p; }
__device__ __forceinline__ unsigned char* fresh_ws(KP p) { GL unsigned char* w = p->ws; asm volatile("" : "+s"(w)); return (unsigned char*)w; }
__device__ __forceinline__ float wave_sum(float v) {
#pragma unroll
    for (int o = 32; o >= 1; o >>= 1) v += __shfl_xor(v, o);
    return v;
}

constexpr int BM = 256, BK = 64, HALF = 128, HTB = HALF * BK * 2, NXCD = 8, WGM = 8;
__device__ __forceinline__ int lds_byte(int r, int c) { const int st = (r >> 4) * 2 + (c >> 5), rr = r & 15, cc = c & 31, ob = rr * 64 + cc * 2; return st * 1024 + (ob ^ (((ob >> 9) & 1) << 5)); }
__device__ __forceinline__ void stage_rc(int b, int& R, int& C) { const int st = b / 1024, sb = b % 1024, swz = sb ^ (((sb >> 9) & 1) << 5); R = (st >> 1) * 16 + swz / 64; C = (st & 1) * 32 + (swz % 64) / 2; }
__device__ __forceinline__ int perm32(int rho) { const int n = rho >> 4, i = rho & 15; return 8 * (i >> 2) + 4 * n + (i & 3); }

struct Unit { const char* a; const char* b; int pm, pn, z; };
struct GSched {
    const char* A; const char* B; unsigned a_tile, b_tile; int az_lin, az_x2, bz_lin; int nM, nN, nZ, G, c;
    __device__ __forceinline__ bool next(int i, Unit& u) const {
        const int ti = i / nZ, z = i - ti * nZ;
        const long L = (long)ti * G + c; const int nwg = nM * nN; if (L >= nwg) return false;
        int wgid = (int)L; { const int q = nwg / NXCD, r = nwg % NXCD, xcd = wgid % NXCD, off = wgid / NXCD; wgid = (xcd < r ? xcd * (q + 1) : r * (q + 1) + (xcd - r) * q) + off; }
        const int nig = WGM * nN, gid = wgid / nig, fm = gid * WGM, gsz = (nM - fm) < WGM ? (nM - fm) : WGM;
        u.pm = fm + ((wgid % nig) % gsz); u.pn = (wgid % nig) / gsz; u.z = z;
        u.a = A + (size_t)u.pm * a_tile + (size_t)(z * az_lin + (z == 2 ? az_x2 : 0));
        u.b = B + (size_t)u.pn * b_tile + (size_t)(z * bz_lin);
        return true;
    }
};
__device__ __forceinline__ GSched make_sched(const void* A, int lda, const void* B, int ldb, int nM, int nN) {
    GSched S; S.A = (const char*)A; S.B = (const char*)B; S.a_tile = (unsigned)(BM * lda * 2); S.b_tile = (unsigned)(BM * ldb * 2);
    S.az_lin = 0; S.az_x2 = 0; S.bz_lin = 0; S.nM = nM; S.nN = nN; S.nZ = 1; S.G = (int)gridDim.x; S.c = (int)blockIdx.x; return S;
}

struct InSched {
    const char* H; const char* W; const char* WV; int nctx, per, G, c;
    __device__ __forceinline__ bool next(int i, Unit& u) const {
        long L = (long)i * G + c;
        if (L < 3648) { const int nwg = 3648, nM = 64, nN = 57;
            int wgid = (int)L; { const int q = nwg / NXCD, r = nwg % NXCD, xcd = wgid % NXCD, off = wgid / NXCD; wgid = (xcd < r ? xcd * (q + 1) : r * (q + 1) + (xcd - r) * q) + off; }
            const int nig = WGM * nN, gid = wgid / nig, fm = gid * WGM, gsz = (nM - fm) < WGM ? (nM - fm) : WGM;
            u.pm = fm + ((wgid % nig) % gsz); u.pn = (wgid % nig) / gsz; u.z = 0;
            u.a = H + (size_t)u.pm * 1048576; u.b = W + (size_t)u.pn * 1048576; return true; }
        L -= 3648;
        if (L < nctx) { const int q = (int)L / per, j = (int)L % per; u.pm = 64 + q; u.pn = per == 57 ? j : (j < 4 ? 4 + j : (j < 12 ? 16 + j : 56)); u.z = 0;
            u.a = H + (size_t)u.pm * 1048576; u.b = W + (size_t)u.pn * 1048576; return true; }
        L -= nctx; if (L >= 288) return false;
        u.pm = (int)L & 3; u.pn = (int)L >> 2; u.z = 1; u.a = WV + (size_t)u.pm * 1048576; u.b = H + (size_t)u.pn * 1048576; return true;
    }
};

template <class Epi, class Sched>
__device__ __forceinline__ void gemm_phase(LAS unsigned char* lds, const int lda, const int ldb, const int K, const Sched& S, const Epi& E) {
    const int tid = opaque_tid(), wid = __builtin_amdgcn_readfirstlane(tid >> 6), lane = tid & 63, wr = wid >> 2, wc = wid & 3, fr = lane & 15, fq = lane >> 4;
    const int nt = K / BK;
    unsigned voffA[2], voffB[2];
#pragma unroll
    for (int i = 0; i < 2; ++i) { int R, C; stage_rc(tid * 16 + i * 8192, R, C); const int Rb = Epi::PERM ? ((R & ~31) + perm32(R & 31)) : R;
        voffA[i] = (unsigned)(R * lda + C) * 2u; voffB[i] = (unsigned)(Rb * ldb + C) * 2u; }
    const size_t kstep = (size_t)(BK * 2);
    const size_t hstepA = (size_t)HALF * lda * 2, hstepB = (size_t)HALF * ldb * 2;
    const unsigned ldsw = (unsigned)wid * 1024u;
    const int aoff = lds_byte(wr * 64 + fr, fq * 8), boff = lds_byte(wc * 32 + fr, fq * 8);
#define PG8_SA(b, h) (((b) * 2 + (h)) * HTB)
#define PG8_SB(b, h) ((4 + (b) * 2 + (h)) * HTB)
#define PG8_STAGE(bufoff, gbase, voff) do { _Pragma("unroll") for (int _i = 0; _i < 2; ++_i) \
        __builtin_amdgcn_global_load_lds((const unsigned*)((const char*)(gbase) + (voff)[_i]), (LAS unsigned*)(lds + (bufoff) + ldsw + _i * 8192), 16, 0, 0); } while (0)
#define PG8_LDA(dst, b, h) do { _Pragma("unroll") for (int m = 0; m < 4; ++m) _Pragma("unroll") for (int k = 0; k < 2; ++k) dst[m][k] = *(const LAS bf16x8*)(lds + PG8_SA(b, h) + aoff + m * 2048 + k * 1024); } while (0)
#define PG8_LDB(dst, b, h) do { _Pragma("unroll") for (int n = 0; n < 2; ++n) _Pragma("unroll") for (int k = 0; k < 2; ++k) dst[n][k] = *(const LAS bf16x8*)(lds + PG8_SB(b, h) + boff + n * 2048 + k * 1024); } while (0)
#define PG8_MMA(ai, bj, At, Bt) do { __builtin_amdgcn_s_setprio(1); _Pragma("unroll") for (int m = 0; m < 4; ++m) _Pragma("unroll") for (int n = 0; n < 2; ++n) _Pragma("unroll") for (int k = 0; k < 2; ++k) \
        acc[ai][bj][m][n] = __builtin_amdgcn_mfma_f32_16x16x32_bf16(Bt[n][k], At[m][k], acc[ai][bj][m][n], 0, 0, 0); __builtin_amdgcn_s_setprio(0); } while (0)
#define PG8_WAIT_V(n) asm volatile("s_waitcnt vmcnt(" #n ")" ::: "memory")
#define PG8_WAIT_L(n) asm volatile("s_waitcnt lgkmcnt(" #n ")" ::: "memory")
#define PG8_BAR __builtin_amdgcn_s_barrier()
#define PG8_SCHED __builtin_amdgcn_sched_barrier(0)
    Unit cur, nxt; int ui = 0;
    if (!S.next(0, cur)) return;
    f32x4 acc[2][2][4][2];
#pragma unroll
    for (int a = 0; a < 2; ++a)
#pragma unroll
        for (int b = 0; b < 2; ++b)
#pragma unroll
            for (int m = 0; m < 4; ++m)
#pragma unroll
                for (int n = 0; n < 2; ++n) acc[a][b][m][n] = (f32x4){0.f, 0.f, 0.f, 0.f};
    bf16x8 At[4][2], B0[2][2], B1[2][2];
    const char* cA = cur.a; const char* cB = cur.b;
    PG8_STAGE(PG8_SB(0, 0), cB, voffB); PG8_STAGE(PG8_SA(0, 0), cA, voffA); PG8_STAGE(PG8_SB(0, 1), cB + hstepB, voffB); PG8_STAGE(PG8_SA(0, 1), cA + hstepA, voffA);
    if (wr == 1) PG8_BAR;
    PG8_WAIT_V(4); PG8_BAR;
    PG8_STAGE(PG8_SB(1, 0), cB + kstep, voffB); PG8_STAGE(PG8_SA(1, 0), cA + kstep, voffA); PG8_STAGE(PG8_SB(1, 1), cB + hstepB + kstep, voffB);
    PG8_WAIT_V(6); PG8_BAR;
    for (;;) {
        const bool has_next = S.next(ui + 1, nxt);
        const char* nA = has_next ? nxt.a : cA; const char* nB = has_next ? nxt.b : cB;
        for (int t = 0; t < nt; t += 2) {
            const bool last = (t == nt - 2);
            const char* a1 = cA + (size_t)(t + 1) * kstep;
            const char* a2 = last ? nA : cA + (size_t)(t + 2) * kstep; const char* b2 = last ? nB : cB + (size_t)(t + 2) * kstep;
            const char* a3 = a2 + kstep; const char* b3 = b2 + kstep;
            PG8_LDB(B0, 0, 0); PG8_SCHED; PG8_LDA(At, 0, 0); PG8_STAGE(PG8_SA(1, 1), a1 + hstepA, voffA);
            PG8_WAIT_L(8); PG8_BAR; PG8_WAIT_L(0); PG8_MMA(0, 0, At, B0); PG8_BAR; PG8_SCHED;
            PG8_LDB(B1, 0, 1); PG8_STAGE(PG8_SB(0, 0), b2, voffB);
            PG8_BAR; PG8_WAIT_L(0); PG8_MMA(0, 1, At, B1); PG8_BAR;
            PG8_LDA(At, 0, 1); PG8_STAGE(PG8_SA(0, 0), a2, voffA);
            PG8_BAR; PG8_WAIT_L(0); PG8_MMA(1, 0, At, B0); PG8_BAR; PG8_SCHED;
            PG8_STAGE(PG8_SB(0, 1), b2 + hstepB, voffB);
            PG8_WAIT_V(6); PG8_BAR; PG8_MMA(1, 1, At, B1); PG8_BAR;
            PG8_LDB(B0, 1, 0); PG8_SCHED; PG8_LDA(At, 1, 0); PG8_STAGE(PG8_SA(0, 1), a2 + hstepA, voffA);
            PG8_WAIT_L(8); PG8_BAR; PG8_WAIT_L(0); PG8_MMA(0, 0, At, B0); PG8_BAR; PG8_SCHED;
            PG8_LDB(B1, 1, 1); PG8_STAGE(PG8_SB(1, 0), b3, voffB);
            PG8_BAR; PG8_WAIT_L(0); PG8_MMA(0, 1, At, B1); PG8_BAR;
            PG8_LDA(At, 1, 1); PG8_STAGE(PG8_SA(1, 0), a3, voffA);
            PG8_BAR; PG8_WAIT_L(0); PG8_MMA(1, 0, At, B0); PG8_BAR; PG8_SCHED;
            PG8_STAGE(PG8_SB(1, 1), b3 + hstepB, voffB);
            PG8_WAIT_V(6); PG8_BAR; PG8_MMA(1, 1, At, B1); PG8_BAR;
        }
        E(acc, cur, wr, wc, fr, fq);
        if (!has_next) break;
#pragma unroll
        for (int a = 0; a < 2; ++a)
#pragma unroll
            for (int b = 0; b < 2; ++b)
#pragma unroll
                for (int m = 0; m < 4; ++m)
#pragma unroll
                    for (int n = 0; n < 2; ++n) acc[a][b][m][n] = (f32x4){0.f, 0.f, 0.f, 0.f};
        cur = nxt; cA = nA; cB = nB; ++ui;
    }
    PG8_WAIT_V(0);
    if (wr == 0) PG8_BAR;
    PG8_BAR;
#undef PG8_SA
#undef PG8_SB
#undef PG8_STAGE
#undef PG8_LDA
#undef PG8_LDB
#undef PG8_MMA
#undef PG8_WAIT_V
#undef PG8_WAIT_L
#undef PG8_BAR
#undef PG8_SCHED
}

struct EpiStore {
    static constexpr bool PERM = true; bf16_t* O; size_t ldc;
    __device__ __forceinline__ void operator()(const f32x4 (&acc)[2][2][4][2], const Unit& u, int wr, int wc, int fr, int fq) const {
        const int row0 = u.pm * BM + wr * 64 + fr, col0 = u.pn * BM + wc * 32 + 8 * fq;
#pragma unroll
        for (int ai = 0; ai < 2; ++ai)
#pragma unroll
            for (int m = 0; m < 4; ++m) { bf16_t* rowp = O + (size_t)(row0 + ai * HALF + m * 16) * ldc + col0;
#pragma unroll
                for (int bj = 0; bj < 2; ++bj) { const f32x4 v0 = acc[ai][bj][m][0], v1 = acc[ai][bj][m][1];
                    u32x4 w; w.x = cvt_pk_bf16(v0[0], v0[1]); w.y = cvt_pk_bf16(v0[2], v0[3]); w.z = cvt_pk_bf16(v1[0], v1[1]); w.w = cvt_pk_bf16(v1[2], v1[3]);
                    *(u32x4*)(rowp + bj * HALF) = w; } }
    }
};
__device__ __forceinline__ int uu_row(int tok) {
    int l, L, base;
    if (tok < NLAT) { l = tok & 2047; L = 2048; base = tok & ~2047; } else { const int t2 = tok - NLAT; l = t2 & 255; L = 256; base = NLAT + (t2 & ~255); }
    const int h = L >> 1; const int s = l < h ? 0 : 1; const int i = l < h ? l : (l == h ? 0 : L - l);
    return base + (i >> 7) * 256 + s * 128 + (i & 127);
}
struct EpiIn {
    static constexpr bool PERM = true; bf16_t* Pm; bf16_t* VT; bf16_t* UU;
    __device__ __forceinline__ void operator()(const f32x4 (&acc)[2][2][4][2], const Unit& u, int wr, int wc, int fr, int fq) const {
        const int row0 = u.pm * BM + wr * 64 + fr, col0 = u.pn * BM + wc * 32 + 8 * fq;
        const bool isuf = u.z == 0 && u.pn >= CUF / 256 && u.pn < CUF / 256 + 4;
        bf16_t* O = u.z ? VT + (u.pn < 64 ? (size_t)(u.pn >> 3) * 1024 * VTB + (u.pn & 7) * 256 : (size_t)(u.pn - 64) * 1024 * VTB + 2048) - (size_t)u.pn * BM : Pm;
        const size_t ldc = u.z ? (size_t)VTB : (size_t)PW;
#pragma unroll
        for (int ai = 0; ai < 2; ++ai)
#pragma unroll
            for (int m = 0; m < 4; ++m) { const int row = row0 + ai * HALF + m * 16;
                bf16_t* rowp = isuf ? UU + (size_t)uu_row(row) * 1024 + (col0 - CUF) : O + (size_t)row * ldc + col0;
#pragma unroll
                for (int bj = 0; bj < 2; ++bj) { const f32x4 v0 = acc[ai][bj][m][0], v1 = acc[ai][bj][m][1];
                    u32x4 w; w.x = cvt_pk_bf16(v0[0], v0[1]); w.y = cvt_pk_bf16(v0[2], v0[3]); w.z = cvt_pk_bf16(v1[0], v1[1]); w.w = cvt_pk_bf16(v1[2], v1[3]);
                    *(u32x4*)(rowp + bj * HALF) = w; } }
    }
};
struct EpiTT {
    static constexpr bool PERM = true; bf16_t* TTlat; bf16_t* TTctx;
    __device__ __forceinline__ void operator()(const f32x4 (&acc)[2][2][4][2], const Unit& u, int wr, int wc, int fr, int fq) const {
        const int row0 = u.pm * BM + wr * 64 + fr; const int cs = fr & 1; const int j0 = wc * 32 + 8 * fq;
        bf16_t* base; int L, chunk;
        if (u.pn < 64) { L = 2048; chunk = u.pn & 7; base = TTlat + (size_t)(u.pn >> 3) * 1024 * 2048; }
        else { L = 256; chunk = 0; base = TTctx + (size_t)(u.pn - 64) * 1024 * 256; }
        const bool first = chunk == 0 && j0 == 0;
#pragma unroll
        for (int ai = 0; ai < 2; ++ai)
#pragma unroll
            for (int m = 0; m < 4; ++m) { const int ch = (row0 + ai * HALF + m * 16) >> 1;
                bf16_t* rowp = base + (size_t)ch * L + (cs ? (L >> 1) : 0) + chunk * 128 + j0;
                const float nyq = __shfl_xor(acc[ai][1][m][0][0], 1);
#pragma unroll
                for (int n = 0; n < 2; ++n) { const f32x4 a = acc[ai][0][m][n], bb = acc[ai][1][m][n];
                    f32x4 v = cs ? a - bb : a + bb;
                    if (n == 0 && first) v[0] = cs ? nyq : a[0];
                    u32x2 w; w.x = cvt_pk_bf16(v[0], v[1]); w.y = cvt_pk_bf16(v[2], v[3]); *(u32x2*)(rowp + n * 4) = w; } }
    }
};
struct EpiFb {
    static constexpr bool PERM = true; bf16_t* Pm; int tok0; int L;
    __device__ __forceinline__ void operator()(const f32x4 (&acc)[2][2][4][2], const Unit& u, int wr, int wc, int fr, int fq) const {
        const int b = u.pn >> 2, ch0 = (u.pn & 3) * 256 + wc * 32 + 8 * fq;
        const int row0 = u.pm * BM + wr * 64 + fr;
#pragma unroll
        for (int ai = 0; ai < 2; ++ai)
#pragma unroll
            for (int m = 0; m < 4; ++m) { asm volatile("" ::: "memory"); bf16_t* rowp = Pm + (size_t)(tok0 + b * L + row0 + ai * HALF + m * 16) * PW + ch0;
#pragma unroll
                for (int bj = 0; bj < 2; ++bj) { const f32x4 v0 = acc[ai][bj][m][0], v1 = acc[ai][bj][m][1];
                    const u32x4 z = *(const u32x4*)(rowp + CZF + bj * HALF);
                    u32x4 w; w.x = cvt_pk_bf16(v0[0] * silu_f(bflo(z.x)), v0[1] * silu_f(bfhi(z.x))); w.y = cvt_pk_bf16(v0[2] * silu_f(bflo(z.y)), v0[3] * silu_f(bfhi(z.y)));
                    w.z = cvt_pk_bf16(v1[0] * silu_f(bflo(z.z)), v1[1] * silu_f(bfhi(z.z))); w.w = cvt_pk_bf16(v1[2] * silu_f(bflo(z.w)), v1[3] * silu_f(bfhi(z.w)));
                    *(u32x4*)(rowp + CA2 + bj * HALF) = w; } }
    }
};
struct EpiMerge {
    static constexpr bool PERM = true; const bf16_t* Pm; float* scratch; bf16_t* M1;
    __device__ __forceinline__ void operator()(const f32x4 (&acc)[2][2][4][2], const Unit& u, int wr, int wc, int fr, int fq) const {
        const int row0 = u.pm * BM + wr * 64 + fr, col0 = u.pn * BM + wc * 32 + 8 * fq;
        unsigned* sp = (unsigned*)scratch + (size_t)blockIdx.x * 32768 + (size_t)opaque_tid() * 4;
        const bf16_t* gp = Pm + (size_t)row0 * PW + CGNA + u.z * 2048 + col0;
        bf16_t* mp = M1 + (size_t)row0 * 2048 + col0;
        const int z = u.z;
#pragma unroll
        for (int ai = 0; ai < 2; ++ai)
#pragma unroll
            for (int m = 0; m < 4; ++m) { asm volatile("" : "+v"(sp));
                const int ro = ai * HALF + m * 16;
                const u32x4 g0 = *(const u32x4*)(gp + (size_t)ro * PW), g1 = *(const u32x4*)(gp + (size_t)ro * PW + HALF);
                u32x4 t0 = {0u, 0u, 0u, 0u}, t1 = {0u, 0u, 0u, 0u};
                if (z > 0) { t0 = *(const u32x4*)sp; t1 = *(const u32x4*)(sp + 2048); }
#pragma unroll
                for (int bj = 0; bj < 2; ++bj) { const u32x4 g = bj ? g1 : g0; const u32x4 t = bj ? t1 : t0; const f32x4 v0 = acc[ai][bj][m][0], v1 = acc[ai][bj][m][1];
                    u32x4 w;
                    w.x = cvt_pk_bf16(bflo(t.x) + v0[0] * sigm_f(bflo(g.x)), bfhi(t.x) + v0[1] * sigm_f(bfhi(g.x))); w.y = cvt_pk_bf16(bflo(t.y) + v0[2] * sigm_f(bflo(g.y)), bfhi(t.y) + v0[3] * sigm_f(bfhi(g.y)));
                    w.z = cvt_pk_bf16(bflo(t.z) + v1[0] * sigm_f(bflo(g.z)), bfhi(t.z) + v1[1] * sigm_f(bfhi(g.z))); w.w = cvt_pk_bf16(bflo(t.w) + v1[2] * sigm_f(bflo(g.w)), bfhi(t.w) + v1[3] * sigm_f(bfhi(g.w)));
                    if (z < 2) *(u32x4*)(sp + bj * 2048) = w; else *(u32x4*)(mp + (size_t)ro * 2048 + bj * HALF) = w; }
                sp += 4096; }
    }
};
struct EpiOut {
    static constexpr bool PERM = true; bf16_t* D; const float* mod;
    __device__ __forceinline__ void operator()(const f32x4 (&acc)[2][2][4][2], const Unit& u, int wr, int wc, int fr, int fq) const {
        const int row0 = u.pm * BM + wr * 64 + fr, col0 = u.pn * BM + wc * 32 + 8 * fq;
        const int vec = u.pm < 64 ? (u.pm >> 3) : 8;
        const float* gp = mod + (size_t)vec * 6144 + 4096 + col0;
        f32x4 gv[2][2];
#pragma unroll
        for (int bj = 0; bj < 2; ++bj)
#pragma unroll
            for (int n = 0; n < 2; ++n) gv[bj][n] = *(const f32x4*)(gp + bj * HALF + n * 4);
#pragma unroll
        for (int ai = 0; ai < 2; ++ai)
#pragma unroll
            for (int m = 0; m < 4; ++m) { bf16_t* rowp = D + (size_t)(row0 + ai * HALF + m * 16) * 2048 + col0;
#pragma unroll
                for (int bj = 0; bj < 2; ++bj) { const f32x4 v0 = acc[ai][bj][m][0] * gv[bj][0], v1 = acc[ai][bj][m][1] * gv[bj][1];
                    u32x4 w; w.x = cvt_pk_bf16(v0[0], v0[1]); w.y = cvt_pk_bf16(v0[2], v0[3]); w.z = cvt_pk_bf16(v1[0], v1[1]); w.w = cvt_pk_bf16(v1[2], v1[3]);
                    *(u32x4*)(rowp + bj * HALF) = w; } }
    }
};

__device__ __forceinline__ void phase_ada(KP p, unsigned char* smem) {
    p = fresh(p);
    float* s = (float*)smem; float* red = s + 9 * 2048; float* mod = (float*)(fresh_ws(p) + OFF_MOD);
    const int tid = opaque_tid();
    for (int i = tid; i < 9 * 2048; i += 512) { const int v = i >> 11, k = i & 2047; const float cv = v < 8 ? ((const float*)p->c)[v * 2048 + k] : ((const float*)p->c_ctx)[k]; s[i] = silu_f(cv); }
    __syncthreads();
    for (int u = blockIdx.x; u < 192; u += gridDim.x) {
        const int l = u / 96, cgp = u % 96, cl = tid & 63, ks = tid >> 6;
        const float* w = ((const float*)p->w_ada) + (size_t)l * 2048 * 6144 + cgp * 64 + cl;
        float a0 = 0, a1 = 0, a2 = 0, a3 = 0, a4 = 0, a5 = 0, a6 = 0, a7 = 0, a8 = 0;
#pragma unroll 4
        for (int k = ks * 256; k < ks * 256 + 256; k += 4) {
            const float w0 = w[(size_t)k * 6144], w1 = w[(size_t)(k + 1) * 6144], w2 = w[(size_t)(k + 2) * 6144], w3 = w[(size_t)(k + 3) * 6144];
#define ADA_ACC(acc, v) do { const f32x4 sv_ = *(const f32x4*)(s + (v) * 2048 + k); acc += sv_[0] * w0 + sv_[1] * w1 + sv_[2] * w2 + sv_[3] * w3; } while (0)
            ADA_ACC(a0, 0); ADA_ACC(a1, 1); ADA_ACC(a2, 2); ADA_ACC(a3, 3); ADA_ACC(a4, 4); ADA_ACC(a5, 5); ADA_ACC(a6, 6); ADA_ACC(a7, 7); ADA_ACC(a8, 8);
#undef ADA_ACC
        }
        float* rp = red + ks * 9 * 64 + cl;
        rp[0] = a0; rp[64] = a1; rp[128] = a2; rp[192] = a3; rp[256] = a4; rp[320] = a5; rp[384] = a6; rp[448] = a7; rp[512] = a8;
        __syncthreads();
        for (int i = tid; i < 9 * 64; i += 512) { float t = 0;
#pragma unroll
            for (int k2 = 0; k2 < 8; ++k2) t += red[k2 * 576 + i];
            const int v = i >> 6, col = cgp * 64 + (i & 63); mod[(size_t)(l * 9 + v) * 6144 + col] = t + ((const float*)p->b_ada)[l * 6144 + col]; }
        __syncthreads();
    }
}

__device__ __forceinline__ void transpose_job(const float* src, int lds_, int c0, bf16_t* dst, int ldd, int r0, int k0, int ncols, int K, unsigned char* smem, int rot) {
    float* tile = (float*)smem;
    const int tid = opaque_tid(), ntn = (ncols + 127) >> 7, ntk = K >> 6, ntot = ntn * ntk, G = gridDim.x;
    const int kk = tid >> 5, nn = (tid & 31) * 4;
    f32x4 v[4];
    int t = (int)((blockIdx.x + G - (rot % G)) % G);
#define TJ_LOAD(tt) do { const int n0_ = ((tt) % ntn) * 128, kb_ = ((tt) / ntn) * 64; \
        _Pragma("unroll") for (int h_ = 0; h_ < 4; ++h_) { float zz_ = 0.f; asm volatile("" : "+v"(zz_)); v[h_] = (f32x4){zz_, zz_, zz_, zz_}; \
            if (n0_ + nn < ncols) v[h_] = *(const f32x4*)(src + (size_t)(kb_ + kk + 16 * h_) * lds_ + c0 + n0_ + nn); } } while (0)
    if (t < ntot) TJ_LOAD(t);
    while (t < ntot) {
        const int n0 = (t % ntn) * 128, kb = (t / ntn) * 64;
#pragma unroll
        for (int h = 0; h < 4; ++h) *(f32x4*)(tile + (kk + 16 * h) * 132 + nn) = v[h];
        const int tn = t + G;
        if (tn < ntot) TJ_LOAD(tn);
        __syncthreads();
        { const int n = tid & 127, kq = (tid >> 7) * 16;
          if (n0 + n < ncols) {
#pragma unroll
              for (int hh = 0; hh < 2; ++hh) { const float* tp = tile + (kq + hh * 8) * 132 + n; u32x4 w;
                  w.x = cvt_pk_bf16(tp[0], tp[132]); w.y = cvt_pk_bf16(tp[2 * 132], tp[3 * 132]); w.z = cvt_pk_bf16(tp[4 * 132], tp[5 * 132]); w.w = cvt_pk_bf16(tp[6 * 132], tp[7 * 132]);
                  *(u32x4*)(dst + (size_t)(r0 + n0 + n) * ldd + k0 + kb + kq + hh * 8) = w; } } }
        __syncthreads();
        t = tn;
    }
#undef TJ_LOAD
}

__device__ __forceinline__ void phase_wprep(KP p, int l, unsigned char* smem) {
    p = fresh(p); unsigned char* wsl = fresh_ws(p);
    bf16_t* WinT = (bf16_t*)(wsl + OFF_WINT); bf16_t* WvT = (bf16_t*)(wsl + OFF_WVT); bf16_t* Wcat = (bf16_t*)(wsl + OFF_WCAT);
    bf16_t* Wout = (bf16_t*)(wsl + OFF_WOUT); bf16_t* W2T = (bf16_t*)(wsl + OFF_W2T);
    const float* win = ((const float*)p->w_in) + (size_t)l * 2048 * INW;
    for (int jb = 0; jb < 9; ++jb) {
        const float* s_ = win; int ld_ = INW, c0 = 0, ldd = 2048, r0 = 0, k0 = 0, nc = 2048, K = 2048, rot = 0; bf16_t* d_ = WinT;
        switch (jb) {
            case 0: break;
            case 1: c0 = 3072; r0 = 2048; nc = 6144; break;
            case 2: c0 = 9248; r0 = 8192; nc = 6144; break;
            case 3: c0 = 9216; r0 = CDT; nc = 32; break;
            case 4: c0 = 2048; d_ = WvT; nc = 1024; rot = 32; break;
            case 5: s_ = ((const float*)p->wb_na) + (size_t)l * 1024 * 2048; ld_ = 2048; d_ = Wcat; ldd = 3072; K = 1024; rot = 64; break;
            case 6: s_ = ((const float*)p->wb_four) + (size_t)l * 1024 * 2048; ld_ = 2048; d_ = Wcat; ldd = 3072; k0 = 1024; K = 1024; rot = 64; break;
            case 7: s_ = ((const float*)p->wb_ssd) + (size_t)l * 1024 * 2048; ld_ = 2048; d_ = Wcat; ldd = 3072; k0 = 2048; K = 1024; rot = 64; break;
            default: s_ = ((const float*)p->w_out) + (size_t)l * 2048 * 2048; ld_ = 2048; d_ = Wout; break;
        }
        transpose_job(s_, ld_, c0, d_, ldd, r0, k0, nc, K, smem, rot);
    }
    { const size_t n16 = (size_t)(PW - CDT - 32) * 2048 * 2 / 16; u32x4* z = (u32x4*)(WinT + (size_t)(CDT + 32) * 2048);
      unsigned zz = 0u; asm volatile("" : "+v"(zz));
      for (size_t i = (size_t)blockIdx.x * 512 + opaque_tid(); i < n16; i += (size_t)gridDim.x * 512) z[i] = (u32x4){zz, zz, zz, zz}; }
    { float* ct = (float*)smem; float* st = ct + 256; const int tid = opaque_tid();
      __syncthreads();
      if (tid < 256) { ct[tid] = cospif((float)tid * (1.f / 128.f)); st[tid] = sinpif((float)tid * (1.f / 128.f)); }
      __syncthreads();
      const float* fw = ((const float*)p->four_w) + (size_t)l * 1024 * 1024;
      for (int u = blockIdx.x; u < 256; u += gridDim.x) {
          const int i0 = (u >> 1) * 8, j = (u & 1) * 512 + tid, g = i0 >> 8, c0 = i0 & 255;
          float ac[8], as[8];
#pragma unroll
          for (int e = 0; e < 8; ++e) { ac[e] = 0.f; as[e] = 0.f; }
          float* dT = st + 256;
          for (int q = tid; q < 4096; q += 512) { const int k2 = q >> 4, e16 = q & 15; const int idx = (k2 * (c0 + (e16 & 7))) & 255; dT[q] = e16 < 8 ? ct[idx] : st[idx]; }
          __syncthreads();
          for (int k2 = 0; k2 < 256; ++k2) { const float w = fw[(size_t)(g * 256 + k2) * 1024 + j];
              const f32x4 c0v = *(const f32x4*)(dT + k2 * 16), c1v = *(const f32x4*)(dT + k2 * 16 + 4), s0v = *(const f32x4*)(dT + k2 * 16 + 8), s1v = *(const f32x4*)(dT + k2 * 16 + 12);
#pragma unroll
              for (int e = 0; e < 4; ++e) { ac[e] += c0v[e] * w; ac[4 + e] += c1v[e] * w; as[e] += s0v[e] * w; as[4 + e] += s1v[e] * w; } }
          __syncthreads();
          u32x4 wc, wsn;
          wc.x = cvt_pk_bf16(ac[0], ac[1]); wc.y = cvt_pk_bf16(ac[2], ac[3]); wc.z = cvt_pk_bf16(ac[4], ac[5]); wc.w = cvt_pk_bf16(ac[6], ac[7]);
          wsn.x = cvt_pk_bf16(as[0], as[1]); wsn.y = cvt_pk_bf16(as[2], as[3]); wsn.z = cvt_pk_bf16(as[4], as[5]); wsn.w = cvt_pk_bf16(as[6], as[7]);
          *(u32x4*)(W2T + (size_t)(j * 2 + 0) * 1024 + i0) = wc; *(u32x4*)(W2T + (size_t)(j * 2 + 1) * 1024 + i0) = wsn; }
      __syncthreads(); }
}

__device__ __forceinline__ void phase_dft(KP p) {
    unsigned char* wsl = fresh_ws(p);
    bf16_t* DL = (bf16_t*)(wsl + OFF_DL); bf16_t* DC = (bf16_t*)(wsl + OFF_DC);
    const size_t gtid = (size_t)blockIdx.x * 512 + opaque_tid(), gstr = (size_t)gridDim.x * 512;
    { const float sc = 0.001381067932f;
      for (size_t it = gtid; it < (size_t)2048 * 2048 / 8; it += gstr) { const int lp = (int)(it >> 8), k0 = (int)(it & 255) * 8;
          float v[8];
#pragma unroll
          for (int e = 0; e < 8; ++e) { const int k = k0 + e; const int kk = k & 1023; const int m = (lp * kk) & 2047; const float x = (float)m * (1.f / 1024.f);
              v[e] = k < 1024 ? sc * cospif(x) : (k == 1024 ? ((lp & 1) ? -sc : sc) : -sc * sinpif(x)); }
          u32x4 w; w.x = cvt_pk_bf16(v[0], v[1]); w.y = cvt_pk_bf16(v[2], v[3]); w.z = cvt_pk_bf16(v[4], v[5]); w.w = cvt_pk_bf16(v[6], v[7]);
          *(u32x4*)(DL + (size_t)lp * 2048 + k0) = w; } }
    { const float sc = 0.00390625f;
      for (size_t it = gtid; it < (size_t)256 * 256 / 8; it += gstr) { const int lp = (int)(it >> 5), k0 = (int)(it & 31) * 8;
          float v[8];
#pragma unroll
          for (int e = 0; e < 8; ++e) { const int k = k0 + e; const int kk = k & 127; const int m = (lp * kk) & 255; const float x = (float)m * (1.f / 128.f);
              v[e] = k < 128 ? sc * cospif(x) : (k == 128 ? ((lp & 1) ? -sc : sc) : -sc * sinpif(x)); }
          u32x4 w; w.x = cvt_pk_bf16(v[0], v[1]); w.y = cvt_pk_bf16(v[2], v[3]); w.z = cvt_pk_bf16(v[4], v[5]); w.w = cvt_pk_bf16(v[6], v[7]);
          *(u32x4*)(DC + (size_t)lp * 256 + k0) = w; } }
}

__device__ __forceinline__ void phase_norm(KP p, int mode) {
    p = fresh(p); unsigned char* wsl = fresh_ws(p); const int tid = opaque_tid();
    const int lane = tid & 63, wv = tid >> 6;
    const bf16_t* D0 = (const bf16_t*)(wsl + OFF_XL); const bf16_t* D1 = D0 + (size_t)NTOK * 2048; bf16_t* h = (bf16_t*)(wsl + OFF_R1); const float* mod = (const float*)(wsl + OFF_MOD);
    const int ntok = mode == 2 ? NLAT : NTOK;
    const int stride = gridDim.x * 8;
    for (int tok0 = blockIdx.x * 8 + wv; tok0 < ntok; tok0 += 2 * stride) {
        const int tok1 = tok0 + stride; const bool has1 = tok1 < ntok; const int tk1 = has1 ? tok1 : tok0;
        const float* src0 = tok0 < NLAT ? ((const float*)p->x) + (size_t)tok0 * 2048 : ((const float*)p->ctx) + (size_t)(tok0 - NLAT) * 2048;
        const float* src1 = tk1 < NLAT ? ((const float*)p->x) + (size_t)tk1 * 2048 : ((const float*)p->ctx) + (size_t)(tk1 - NLAT) * 2048;
        f32x4 v[2][8]; float ss[2] = {0.f, 0.f};
#pragma unroll
        for (int i = 0; i < 8; ++i) { v[0][i] = *(const f32x4*)(src0 + (i * 64 + lane) * 4); v[1][i] = *(const f32x4*)(src1 + (i * 64 + lane) * 4); }
        if (mode >= 1) {
#pragma unroll
            for (int i = 0; i < 8; ++i) { const u32x2 d0 = *(const u32x2*)(D0 + (size_t)tok0 * 2048 + (i * 64 + lane) * 4), d1 = *(const u32x2*)(D0 + (size_t)tk1 * 2048 + (i * 64 + lane) * 4);
                v[0][i][0] += bflo(d0.x); v[0][i][1] += bfhi(d0.x); v[0][i][2] += bflo(d0.y); v[0][i][3] += bfhi(d0.y);
                v[1][i][0] += bflo(d1.x); v[1][i][1] += bfhi(d1.x); v[1][i][2] += bflo(d1.y); v[1][i][3] += bfhi(d1.y); } }
        if (mode == 2) {
#pragma unroll
            for (int i = 0; i < 8; ++i) { const u32x2 d0 = *(const u32x2*)(D1 + (size_t)tok0 * 2048 + (i * 64 + lane) * 4), d1 = *(const u32x2*)(D1 + (size_t)tk1 * 2048 + (i * 64 + lane) * 4);
                v[0][i][0] += bflo(d0.x); v[0][i][1] += bfhi(d0.x); v[0][i][2] += bflo(d0.y); v[0][i][3] += bfhi(d0.y);
                v[1][i][0] += bflo(d1.x); v[1][i][1] += bfhi(d1.x); v[1][i][2] += bflo(d1.y); v[1][i][3] += bfhi(d1.y); } }
#pragma unroll
        for (int q = 0; q < 2; ++q)
#pragma unroll
            for (int i = 0; i < 8; ++i) ss[q] += v[q][i][0] * v[q][i][0] + v[q][i][1] * v[q][i][1] + v[q][i][2] * v[q][i][2] + v[q][i][3] * v[q][i][3];
#pragma unroll
        for (int o = 32; o >= 1; o >>= 1) { ss[0] += __shfl_xor(ss[0], o); ss[1] += __shfl_xor(ss[1], o); }
#pragma unroll
        for (int q = 0; q < 2; ++q) {
            if (q == 1 && !has1) break;
            const int tok = q ? tok1 : tok0;
            const float rstd = rsqrtf(ss[q] * (1.f / 2048.f) + 1e-6f);
            if (mode == 2) {
#pragma unroll
                for (int i = 0; i < 8; ++i) { const int c = (i * 64 + lane) * 4; const f32x4 w = *(const f32x4*)(((const float*)p->final_norm_w) + c); *(f32x4*)(((float*)p->out) + (size_t)tok * 2048 + c) = v[q][i] * rstd * w; }
            } else {
                const int vec = tok < NLAT ? (tok >> 11) : 8; const float* mp = mod + (size_t)(mode * 9 + vec) * 6144; const float* nw = ((const float*)p->norm_w) + mode * 2048;
#pragma unroll
                for (int i = 0; i < 8; ++i) { const int c = (i * 64 + lane) * 4; const f32x4 w = *(const f32x4*)(nw + c), sh = *(const f32x4*)(mp + c), sc = *(const f32x4*)(mp + 2048 + c);
                    const f32x4 o = (v[q][i] * rstd * w) * (sc + 1.f) + sh;
                    u32x2 pk; pk.x = cvt_pk_bf16(o[0], o[1]); pk.y = cvt_pk_bf16(o[2], o[3]); *(u32x2*)(h + (size_t)tok * 2048 + c) = pk; }
            }
        }
    }
}

__device__ __forceinline__ void phase_conv(KP p, int layer, unsigned char* smem) {
    float2* tab = (float2*)smem;
    p = fresh(p); unsigned char* wsl = fresh_ws(p);
    const int tid = opaque_tid();
    __syncthreads();
    for (int i = tid; i < 2048; i += 512) { const int pos = i >> 5, jj = i & 31; const float inv = exp2f(-(float)jj * (13.287712379549449f / 32.f)); const float ang = (float)pos * inv; tab[i] = make_float2(__cosf(ang), __sinf(ang)); }
    __syncthreads();
    const bf16_t* Pm = (const bf16_t*)(wsl + OFF_P); bf16_t* U = (bf16_t*)(wsl + OFF_R1);
    float* dtv = (float*)(wsl + OFF_DTV); float* dec = (float*)(wsl + OFF_DEC);
    const int ch = tid * 4;
    float w[7][4], bias[4];
#pragma unroll
    for (int j = 0; j < 7; ++j) { const f32x4 t = *(const f32x4*)(((const float*)p->conv_w) + ((size_t)layer * 7 + j) * 2048 + ch); w[j][0] = t[0]; w[j][1] = t[1]; w[j][2] = t[2]; w[j][3] = t[3]; }
    { const f32x4 t = *(const f32x4*)(((const float*)p->conv_b) + (size_t)layer * 2048 + ch); bias[0] = t[0]; bias[1] = t[1]; bias[2] = t[2]; bias[3] = t[3]; }
    const bool ropech = ch >= 1024; const int n = (ch - 1024) & 127, half = n >> 6, i64 = n & 63, jj0 = i64 & 31; const bool first = i64 < 32;
    for (int u = (int)gridDim.x - 1 - (int)blockIdx.x; u < 1152; u += gridDim.x) {
        int tokbase, s0, L; bool lat;
        if (u < 1024) { tokbase = (u >> 7) * 2048; s0 = (u & 127) * 16; L = 2048; lat = true; } else { const int v = u - 1024; tokbase = NLAT + (v >> 4) * 256; s0 = (v & 15) * 16; L = 256; lat = false; }
        float xr[22][4];
#pragma unroll
        for (int i = 0; i < 22; ++i) { const int s = s0 - 3 + i; u32x2 t = {0u, 0u}; if (s >= 0 && s < L) t = *(const u32x2*)(Pm + (size_t)(tokbase + s) * PW + CXBC + ch);
            xr[i][0] = bflo(t.x); xr[i][1] = bfhi(t.x); xr[i][2] = bflo(t.y); xr[i][3] = bfhi(t.y); }
#pragma unroll
        for (int t = 0; t < 16; ++t) { float o[4];
#pragma unroll
            for (int k = 0; k < 4; ++k) { float a = bias[k];
#pragma unroll
                for (int j = 0; j < 7; ++j) a += w[j][k] * xr[t + j][k];
                o[k] = silu_f(a); }
            const int l = s0 + t; const int pos = half ? (l & 63) : (l >> 6);
#pragma unroll
            for (int k = 0; k < 4; ++k) { const float pv = __shfl_xor(o[k], 8);
                if (lat && ropech) { const float2 cs = tab[pos * 32 + jj0 + k]; o[k] = first ? (o[k] * cs.x - pv * cs.y) : (pv * cs.y + o[k] * cs.x); } }
            u32x2 pk; pk.x = cvt_pk_bf16(o[0], o[1]); pk.y = cvt_pk_bf16(o[2], o[3]);
            *(u32x2*)(U + (size_t)(tokbase + l) * 2048 + ch) = pk; }
        { const int t = tid >> 5, dh = tid & 31; const size_t tok = (size_t)(tokbase + s0 + t);
          const float raw = bf2f(Pm[tok * PW + CDT + dh]) + ((const float*)p->dt_bias)[layer * 32 + dh];
          const float ex = __expf(raw); const float dt = raw > 15.f ? raw : (ex < 0.02f ? ex * (1.f - ex * (0.5f - ex * (1.f / 3.f))) : __logf(1.f + ex)); const float a = -__expf(((const float*)p->a_log)[layer * 32 + dh]);
          dtv[tok * 32 + dh] = dt; dec[tok * 32 + dh] = dt * a; }
    }
    __syncthreads();
}

constexpr int ATT_VT_OFF = 65536, ATT_VT_ROW = 528, ATT_RPB_OFF = 133120;
template <bool WIN>
__device__ __forceinline__ void attn_unit(KP p, unsigned char* wsl, LAS unsigned char* lds, int tid, int layer, int b, int h, int r, int j, int qtok0) {
    asm volatile("" : "+v"(tid));
    const int lane = tid & 63, c16 = lane & 15, q4 = lane >> 4;
    const int k32 = (c16 >> 2) * 8 + (c16 & 3);
    bf16_t* Pm = (bf16_t*)(wsl + OFF_P); const bf16_t* VT = (const bf16_t*)(wsl + OFF_VT);
    bf16_t* orow = Pm + (size_t)(qtok0 + c16) * PW + h * 128 + q4 * 4;
    bf16x8 qf[4];
    { const bf16_t* qp = Pm + (size_t)(qtok0 + c16) * PW + CQ + h * 128 + q4 * 8;
#pragma unroll
      for (int kk = 0; kk < 4; ++kk) qf[kk] = *(const bf16x8*)(qp + kk * 32); }
    const int start = WIN ? min(max(r - 4, 0), 24) : 0;
    const int kstart = WIN ? min(max(j * 16 - 8, 0), 32) : 0;
    const int kc0 = NLAT + b * 256, kw0 = b * 2048 + start * 64 + kstart, kwl = start * 64 + kstart;
    const float scale = 0.08838834764831845f;
    f32x4 s[16];
    unsigned pkA[16][2]; float mA = -3.0e38f, sumA = 0.f;
#pragma unroll
    for (int g4 = 0; g4 < 4; ++g4) {
        bf16x8 kf[4][4];
        if (!WIN) {
#pragma unroll
            for (int tt = 0; tt < 4; ++tt) { const int t_ = g4 * 4 + tt; const bf16_t* kp = Pm + (size_t)(kc0 + (t_ >> 1) * 32 + k32 + (t_ & 1) * 4) * PW + CK + h * 128 + q4 * 8;
#pragma unroll
                for (int kk = 0; kk < 4; ++kk) kf[tt][kk] = *(const bf16x8*)(kp + kk * 32); }
        }
#pragma unroll
        for (int tt = 0; tt < 4; ++tt) { const int t = g4 * 4 + tt;
            f32x4 a = {0.f, 0.f, 0.f, 0.f};
#pragma unroll
            for (int kk = 0; kk < 4; ++kk) { const int keyl = (t >> 1) * 32 + k32 + (t & 1) * 4;
                const bf16x8 kfr = WIN ? *(const LAS bf16x8*)(lds + keyl * 256 + (((kk * 4 + q4) ^ (keyl & 15)) * 16)) : kf[tt][kk];
                a = __builtin_amdgcn_mfma_f32_16x16x32_bf16(kfr, qf[kk], a, 0, 0, 0); }
#pragma unroll
            for (int i = 0; i < 4; ++i) { a[i] *= scale; mA = fmaxf(mA, a[i]); }
            s[t] = a; }
    }
    mA = fmaxf(mA, __shfl_xor(mA, 16)); mA = fmaxf(mA, __shfl_xor(mA, 32));
#pragma unroll
    for (int t = 0; t < 16; ++t) { const float e0 = __expf(s[t][0] - mA), e1 = __expf(s[t][1] - mA), e2 = __expf(s[t][2] - mA), e3 = __expf(s[t][3] - mA);
        sumA += (e0 + e1) + (e2 + e3); pkA[t][0] = cvt_pk_bf16(e0, e1); pkA[t][1] = cvt_pk_bf16(e2, e3); }
    unsigned pkB[WIN ? 16 : 1][2]; float mB = -3.0e38f, sumB = 0.f;
    if (WIN) {
        const int qcol = j * 16 + c16, qstart = min(max(qcol - 8, 0), 48);
#pragma unroll
        for (int g4 = 0; g4 < 4; ++g4) {
            bf16x8 kf[4][4];
#pragma unroll
            for (int tt = 0; tt < 4; ++tt) { const int t = g4 * 4 + tt; const bf16_t* kp = Pm + (size_t)(kw0 + (t >> 1) * 64 + k32 + (t & 1) * 4) * PW + CK + h * 128 + q4 * 8;
#pragma unroll
                for (int kk = 0; kk < 4; ++kk) kf[tt][kk] = *(const bf16x8*)(kp + kk * 32); }
#pragma unroll
            for (int tt = 0; tt < 4; ++tt) { const int t = g4 * 4 + tt; const int kr = t >> 1, ct = t & 1;
                f32x4 a = {0.f, 0.f, 0.f, 0.f};
#pragma unroll
                for (int kk = 0; kk < 4; ++kk) a = __builtin_amdgcn_mfma_f32_16x16x32_bf16(kf[tt][kk], qf[kk], a, 0, 0, 0);
                const int dr = start + kr - r + 7;
                const LAS float* bp = (const LAS float*)(lds + ATT_RPB_OFF) + dr * 31;
#pragma unroll
                for (int i = 0; i < 4; ++i) { const int kcol = kstart + q4 * 8 + ct * 4 + i; const bool valid = kcol >= qstart && kcol < qstart + 16;
                    float v = -1e30f; if (valid) v = a[i] * scale + bp[kcol - qcol + 15];
                    a[i] = v; mB = fmaxf(mB, v); }
                s[t] = a; }
        }
        mB = fmaxf(mB, __shfl_xor(mB, 16)); mB = fmaxf(mB, __shfl_xor(mB, 32));
#pragma unroll
        for (int t = 0; t < 16; ++t) { const float e0 = __expf(s[t][0] - mB), e1 = __expf(s[t][1] - mB), e2 = __expf(s[t][2] - mB), e3 = __expf(s[t][3] - mB);
            sumB += (e0 + e1) + (e2 + e3); pkB[t][0] = cvt_pk_bf16(e0, e1); pkB[t][1] = cvt_pk_bf16(e2, e3); }
    }
    const float m = WIN ? fmaxf(mA, mB) : mA;
    const float fA = WIN ? __expf(mA - m) : 1.f, fB = WIN ? __expf(mB - m) : 0.f;
    float sum = sumA * fA + sumB * fB;
    sum += __shfl_xor(sum, 16); sum += __shfl_xor(sum, 32);
    const float inv = 1.f / sum, gA = fA * inv, gB = fB * inv;
    u32x4 vg[2][8];
#define ATT_VLOAD(bufi, dtt) do { const bf16_t* vp_ = VT + ((size_t)b * 1024 + h * 128 + (dtt) * 16 + c16) * VTB + q4 * 8; \
        _Pragma("unroll") for (int u_ = 0; u_ < 8; ++u_) vg[bufi][u_] = *(const u32x4*)(vp_ + (WIN ? kwl + u_ * 64 : 2048 + u_ * 32)); } while (0)
    u32x2 outw[8];
    u32x2 zg[8];
#pragma unroll
    for (int dt = 0; dt < 8; ++dt) zg[dt] = *(const u32x2*)(orow + CZNA + dt * 16);
    ATT_VLOAD(0, 0);
#pragma unroll
    for (int dt = 0; dt < 8; ++dt) {
        if (dt + 1 < 8) ATT_VLOAD((dt + 1) & 1, dt + 1);
        f32x4 oA = {0.f, 0.f, 0.f, 0.f}, oB = {0.f, 0.f, 0.f, 0.f};
#pragma unroll
        for (int u = 0; u < 8; ++u) {
            u32x4 vv;
            if (WIN) vv = *(const LAS u32x4*)(lds + ATT_VT_OFF + (dt * 16 + c16) * ATT_VT_ROW + (u * 32 + q4 * 8) * 2);
            else vv = vg[dt & 1][u];
            const u32x4 pp = {pkA[2 * u][0], pkA[2 * u][1], pkA[2 * u + 1][0], pkA[2 * u + 1][1]};
            oA = __builtin_amdgcn_mfma_f32_16x16x32_bf16(__builtin_bit_cast(bf16x8, vv), __builtin_bit_cast(bf16x8, pp), oA, 0, 0, 0); }
        if (WIN) {
#pragma unroll
            for (int u = 0; u < 8; ++u) {
                const u32x4 vv = vg[dt & 1][u]; const u32x4 pp = {pkB[WIN ? 2 * u : 0][0], pkB[WIN ? 2 * u : 0][1], pkB[WIN ? 2 * u + 1 : 0][0], pkB[WIN ? 2 * u + 1 : 0][1]};
                oB = __builtin_amdgcn_mfma_f32_16x16x32_bf16(__builtin_bit_cast(bf16x8, vv), __builtin_bit_cast(bf16x8, pp), oB, 0, 0, 0); }
        }
        const u32x2 z = zg[dt];
        const float o0 = oA[0] * gA + oB[0] * gB, o1 = oA[1] * gA + oB[1] * gB, o2 = oA[2] * gA + oB[2] * gB, o3 = oA[3] * gA + oB[3] * gB;
        outw[dt].x = cvt_pk_bf16(o0 * silu_f(bflo(z.x)), o1 * silu_f(bfhi(z.x))); outw[dt].y = cvt_pk_bf16(o2 * silu_f(bflo(z.y)), o3 * silu_f(bfhi(z.y)));
    }
#undef ATT_VLOAD
#pragma unroll
    for (int dt = 0; dt < 8; ++dt) *(u32x2*)(orow + CA1 + dt * 16) = outw[dt];
}

__device__ __forceinline__ void phase_attn(KP p, int layer, unsigned char* smem) {
    p = fresh(p); unsigned char* wsl = fresh_ws(p); const int tid = opaque_tid();
    LAS unsigned char* lds = (LAS unsigned char*)smem;
    const int wv = __builtin_amdgcn_readfirstlane(tid >> 6);
    const bf16_t* Pm = (const bf16_t*)(wsl + OFF_P); const bf16_t* VT = (const bf16_t*)(wsl + OFF_VT);
    for (int bu = blockIdx.x; bu < 256; bu += gridDim.x) { const int b = bu >> 5, h = (bu >> 2) & 7, rg = bu & 3, kc0 = NLAT + b * 256;
        __syncthreads();
        int ts = tid; asm volatile("" : "+v"(ts));
#pragma unroll
        for (int k = 0; k < 8; ++k) { const int idx = ts + 512 * k;
            { const int key = idx >> 4, ch = idx & 15; *(LAS u32x4*)(lds + key * 256 + ((ch ^ (key & 15)) * 16)) = *(const u32x4*)(Pm + (size_t)(kc0 + key) * PW + CK + h * 128 + ch * 8); }
            { const int d = idx >> 5, pc = idx & 31; *(LAS u32x4*)(lds + ATT_VT_OFF + d * ATT_VT_ROW + pc * 16) = *(const u32x4*)(VT + ((size_t)b * 1024 + h * 128 + d) * VTB + 2048 + pc * 8); } }
        if (ts < 465) *(LAS float*)(lds + ATT_RPB_OFF + ts * 4) = ((const float*)p->rpb)[(size_t)(layer * 8 + h) * 465 + ts];
        __syncthreads();
        const int r = rg * 8 + wv;
        for (int j = 0; j < 4; ++j) attn_unit<true>(p, wsl, lds, tid, layer, b, h, r, j, b * 2048 + r * 64 + j * 16);
    }
    if (layer == 0)
        for (int bu = (int)gridDim.x - 1 - (int)blockIdx.x; bu < 128; bu += gridDim.x) { const int wu = bu * 8 + wv; const int qb = wu & 15, h = (wu >> 4) & 7, b = wu >> 7;
            attn_unit<false>(p, wsl, lds, tid, layer, b, h, 0, 0, NLAT + b * 256 + qb * 16); }
    __syncthreads();
}

__device__ __forceinline__ int scan_tok(int b, int dir, int s) {
    if (s < 256) return NLAT + b * 256 + (dir ? 255 - s : s);
    const int ss = s - 256; return b * 2048 + (dir ? 2047 - ss : ss);
}
__device__ __forceinline__ void phase_scan(KP p, unsigned char* smem) {
    constexpr int O_C = 0, O_B = 17408, O_BT = 34816, O_XT = 53248, O_CS = 62464, O_DT = 62720, SBUF = 62976, O_H = 2 * SBUF;
    const int tid = opaque_tid(); unsigned char* wsl = fresh_ws(p);
    LAS unsigned char* lds = (LAS unsigned char*)smem;
    const bf16_t* U = (const bf16_t*)(wsl + OFF_R1); bf16_t* Pm = (bf16_t*)(wsl + OFF_P);
    const float* dtv = (const float*)(wsl + OFF_DTV); const float* dag = (const float*)(wsl + OFF_DEC);
    const int lane = tid & 63, w = tid >> 6, c16 = lane & 15, q4 = lane >> 4;
    const int it = w >> 1, ptb = (w & 1) * 2;
    for (int u = blockIdx.x; u < 256; u += gridDim.x) {
        const int b = u >> 5, dir = (u >> 4) & 1, head = u & 15, g = head >> 2, dh = dir * 16 + head;
        const int ycol = (dir ? CYB : CYF) + head * 64;
        f32x4 hacc[4];
#pragma unroll
        for (int e = 0; e < 4; ++e) hacc[e] = (f32x4){0.f, 0.f, 0.f, 0.f};
        __syncthreads();
        for (int i = tid; i < 64 * 136 * 2 / 16; i += 512) *(LAS u32x4*)(lds + O_H + i * 16) = (u32x4){0u, 0u, 0u, 0u};
        u32x4 rc[2], rb[2]; u32x2 rx[2]; float rdt = 0.f, rda = 0.f;
        const int pr = tid >> 4, pc = tid & 15;
#define SCAN_LOAD(chunk) do { const int s0_ = (chunk) * 64; \
            _Pragma("unroll") for (int k_ = 0; k_ < 2; ++k_) { const size_t tk_ = (size_t)scan_tok(b, dir, s0_ + 2 * pr + k_); \
                rc[k_] = *(const u32x4*)(U + tk_ * 2048 + 1536 + g * 128 + pc * 8); rb[k_] = *(const u32x4*)(U + tk_ * 2048 + 1024 + g * 128 + pc * 8); \
                rx[k_] = *(const u32x2*)(U + tk_ * 2048 + head * 64 + pc * 4); } \
            if (tid < 64) { const size_t tk_ = (size_t)scan_tok(b, dir, s0_ + tid); rdt = dtv[tk_ * 32 + dh]; rda = dag[tk_ * 32 + dh]; } } while (0)
#define SCAN_STORE(bufi) do { LAS unsigned char* sb_ = lds + (bufi) * SBUF; \
            _Pragma("unroll") for (int k_ = 0; k_ < 2; ++k_) { \
                *(LAS u32x4*)(sb_ + O_C + ((2 * pr + k_) * 136 + pc * 8) * 2) = rc[k_]; *(LAS u32x4*)(sb_ + O_B + ((2 * pr + k_) * 136 + pc * 8) * 2) = rb[k_]; } \
            { const unsigned b0_[4] = {rb[0].x, rb[0].y, rb[0].z, rb[0].w}, b1_[4] = {rb[1].x, rb[1].y, rb[1].z, rb[1].w}; \
              _Pragma("unroll") for (int e_ = 0; e_ < 4; ++e_) { \
                  *(LAS unsigned*)(sb_ + O_BT + ((pc * 8 + 2 * e_) * 72 + 2 * pr) * 2) = (b0_[e_] & 0xffffu) | (b1_[e_] << 16); \
                  *(LAS unsigned*)(sb_ + O_BT + ((pc * 8 + 2 * e_ + 1) * 72 + 2 * pr) * 2) = (b0_[e_] >> 16) | (b1_[e_] & 0xffff0000u); } } \
            { const unsigned x0_[2] = {rx[0].x, rx[0].y}, x1_[2] = {rx[1].x, rx[1].y}; \
              _Pragma("unroll") for (int e_ = 0; e_ < 2; ++e_) { \
                  *(LAS unsigned*)(sb_ + O_XT + ((pc * 4 + 2 * e_) * 72 + 2 * pr) * 2) = (x0_[e_] & 0xffffu) | (x1_[e_] << 16); \
                  *(LAS unsigned*)(sb_ + O_XT + ((pc * 4 + 2 * e_ + 1) * 72 + 2 * pr) * 2) = (x0_[e_] >> 16) | (x1_[e_] & 0xffff0000u); } } \
            if (tid < 64) { float v_ = rda; \
                _Pragma("unroll") for (int o_ = 1; o_ < 64; o_ <<= 1) { const float t_ = __shfl_up(v_, o_); if (lane >= o_) v_ += t_; } \
                *(LAS float*)(sb_ + O_CS + tid * 4) = v_; *(LAS float*)(sb_ + O_DT + tid * 4) = rdt; } } while (0)
        SCAN_LOAD(0);
        SCAN_STORE(0);
        SCAN_LOAD(1);
        __syncthreads();
        for (int c = 0; c < 36; ++c) {
            const int cur = c & 1;
            const LAS unsigned char* sb = lds + cur * SBUF;
            const LAS unsigned char* Hc = lds + O_H + cur * 17408;
            LAS unsigned char* Hn = lds + O_H + (cur ^ 1) * 17408;
            const int irow = it * 16 + c16;
            const float cs_i = *(const LAS float*)(sb + O_CS + irow * 4);
            const float cs_last = *(const LAS float*)(sb + O_CS + 63 * 4);
            bf16x8 xf[4][2];
#pragma unroll
            for (int pt = 0; pt < 4; ++pt)
#pragma unroll
                for (int uu = 0; uu < 2; ++uu) { const LAS unsigned char* xp = sb + O_XT + ((pt * 16 + c16) * 72 + uu * 32 + q4 * 4) * 2;
                    const u32x2 va = *(const LAS u32x2*)xp, vb = *(const LAS u32x2*)(xp + 32); const u32x4 vv = {va.x, va.y, vb.x, vb.y}; xf[pt][uu] = __builtin_bit_cast(bf16x8, vv); }
            bf16x8 cf[4];
#pragma unroll
            for (int kk = 0; kk < 4; ++kk) cf[kk] = *(const LAS bf16x8*)(sb + O_C + (irow * 136 + kk * 32 + q4 * 8) * 2);
            f32x4 yacc[2];
#pragma unroll
            for (int e = 0; e < 2; ++e) { f32x4 a = {0.f, 0.f, 0.f, 0.f};
#pragma unroll
                for (int kk = 0; kk < 4; ++kk) a = __builtin_amdgcn_mfma_f32_16x16x32_bf16(*(const LAS bf16x8*)(Hc + (((ptb + e) * 16 + c16) * 136 + kk * 32 + q4 * 8) * 2), cf[kk], a, 0, 0, 0);
                yacc[e] = a * __expf(cs_i); }
            unsigned pk[4][2];
#pragma unroll
            for (int jt = 0; jt < 4; ++jt) { pk[jt][0] = 0u; pk[jt][1] = 0u;
                if (jt <= it) { f32x4 a = {0.f, 0.f, 0.f, 0.f};
#pragma unroll
                    for (int kk = 0; kk < 4; ++kk) a = __builtin_amdgcn_mfma_f32_16x16x32_bf16(*(const LAS bf16x8*)(sb + O_B + ((jt * 16 + c16) * 136 + kk * 32 + q4 * 8) * 2), cf[kk], a, 0, 0, 0);
                    const f32x4 csj = *(const LAS f32x4*)(sb + O_CS + (jt * 16 + q4 * 4) * 4), dtj = *(const LAS f32x4*)(sb + O_DT + (jt * 16 + q4 * 4) * 4);
                    float m[4];
#pragma unroll
                    for (int r = 0; r < 4; ++r) { const int j = jt * 16 + q4 * 4 + r; m[r] = (j <= irow) ? a[r] * __expf(cs_i - csj[r]) * dtj[r] : 0.f; }
                    pk[jt][0] = cvt_pk_bf16(m[0], m[1]); pk[jt][1] = cvt_pk_bf16(m[2], m[3]); } }
#pragma unroll
            for (int uu = 0; uu < 2; ++uu)
                if (2 * uu <= it) { const u32x4 mm = {pk[2 * uu][0], pk[2 * uu][1], pk[2 * uu + 1][0], pk[2 * uu + 1][1]}; const bf16x8 mf = __builtin_bit_cast(bf16x8, mm);
#pragma unroll
                    for (int e = 0; e < 2; ++e) { const LAS unsigned char* xp = sb + O_XT + (((ptb + e) * 16 + c16) * 72 + uu * 32 + q4 * 4) * 2;
                        const u32x2 va = *(const LAS u32x2*)xp, vb = *(const LAS u32x2*)(xp + 32); const u32x4 vv = {va.x, va.y, vb.x, vb.y};
                        yacc[e] = __builtin_amdgcn_mfma_f32_16x16x32_bf16(__builtin_bit_cast(bf16x8, vv), mf, yacc[e], 0, 0, 0); } }
            { const size_t tok = (size_t)scan_tok(b, dir, c * 64 + irow);
#pragma unroll
              for (int e = 0; e < 2; ++e) { u32x2 o; o.x = cvt_pk_bf16(yacc[e][0], yacc[e][1]); o.y = cvt_pk_bf16(yacc[e][2], yacc[e][3]);
                  *(u32x2*)(Pm + tok * PW + ycol + (ptb + e) * 16 + q4 * 4) = o; } }
            { const float dl = __expf(cs_last);
#pragma unroll
              for (int pt = 0; pt < 4; ++pt) hacc[pt] = hacc[pt] * dl;
#pragma unroll
              for (int uu = 0; uu < 2; ++uu) {
                  const LAS unsigned char* bp = sb + O_BT + ((w * 16 + c16) * 72 + uu * 32 + q4 * 4) * 2;
                  const u32x2 ba = *(const LAS u32x2*)bp, bb = *(const LAS u32x2*)(bp + 32);
                  const f32x4 cs0 = *(const LAS f32x4*)(sb + O_CS + (uu * 32 + q4 * 4) * 4), cs1 = *(const LAS f32x4*)(sb + O_CS + (uu * 32 + 16 + q4 * 4) * 4);
                  const f32x4 d0 = *(const LAS f32x4*)(sb + O_DT + (uu * 32 + q4 * 4) * 4), d1 = *(const LAS f32x4*)(sb + O_DT + (uu * 32 + 16 + q4 * 4) * 4);
                  u32x4 sb;
                  sb.x = cvt_pk_bf16(bflo(ba.x) * __expf(cs_last - cs0[0]) * d0[0], bfhi(ba.x) * __expf(cs_last - cs0[1]) * d0[1]);
                  sb.y = cvt_pk_bf16(bflo(ba.y) * __expf(cs_last - cs0[2]) * d0[2], bfhi(ba.y) * __expf(cs_last - cs0[3]) * d0[3]);
                  sb.z = cvt_pk_bf16(bflo(bb.x) * __expf(cs_last - cs1[0]) * d1[0], bfhi(bb.x) * __expf(cs_last - cs1[1]) * d1[1]);
                  sb.w = cvt_pk_bf16(bflo(bb.y) * __expf(cs_last - cs1[2]) * d1[2], bfhi(bb.y) * __expf(cs_last - cs1[3]) * d1[3]);
                  const bf16x8 bfr = __builtin_bit_cast(bf16x8, sb);
#pragma unroll
                  for (int pt = 0; pt < 4; ++pt) hacc[pt] = __builtin_amdgcn_mfma_f32_16x16x32_bf16(bfr, xf[pt][uu], hacc[pt], 0, 0, 0); }
#pragma unroll
              for (int pt = 0; pt < 4; ++pt) { u32x2 o; o.x = cvt_pk_bf16(hacc[pt][0], hacc[pt][1]); o.y = cvt_pk_bf16(hacc[pt][2], hacc[pt][3]);
                  *(LAS u32x2*)(Hn + ((pt * 16 + c16) * 136 + w * 16 + q4 * 4) * 2) = o; } }
            if (c + 1 < 36) SCAN_STORE(cur ^ 1);
            if (c + 2 < 36) SCAN_LOAD(c + 2);
            __syncthreads();
        }
#undef SCAN_LOAD
#undef SCAN_STORE
    }
}

__device__ __forceinline__ void phase_ssd_final(KP p, int layer, int ntok) {
    p = fresh(p); unsigned char* wsl = fresh_ws(p); const int tid = opaque_tid();
    const int lane = tid & 63, wv = tid >> 6;
    const bf16_t* U = (const bf16_t*)(wsl + OFF_R1); bf16_t* Pm = (bf16_t*)(wsl + OFF_P);
    const int ch = lane * 16; const float dsk = ((const float*)p->ssd_d)[layer * 16 + (lane >> 2)];
    for (int tok = blockIdx.x * 8 + wv; tok < ntok; tok += gridDim.x * 8) {
        bf16_t* row = Pm + (size_t)tok * PW;
        float ys[16]; float ss = 0.f;
#pragma unroll
        for (int hh = 0; hh < 2; ++hh) {
            const u32x4 xv = *(const u32x4*)(U + (size_t)tok * 2048 + ch + hh * 8), yf = *(const u32x4*)(row + CYF + ch + hh * 8), yb = *(const u32x4*)(row + CYB + ch + hh * 8), zs = *(const u32x4*)(row + CZS + ch + hh * 8);
            const unsigned xa[4] = {xv.x, xv.y, xv.z, xv.w}, fa[4] = {yf.x, yf.y, yf.z, yf.w}, ba[4] = {yb.x, yb.y, yb.z, yb.w}, za[4] = {zs.x, zs.y, zs.z, zs.w};
#pragma unroll
            for (int e = 0; e < 4; ++e) { const float v0 = (dsk * bflo(xa[e]) + bflo(fa[e]) + bflo(ba[e])) * silu_f(bflo(za[e])); const float v1 = (dsk * bfhi(xa[e]) + bfhi(fa[e]) + bfhi(ba[e])) * silu_f(bfhi(za[e]));
                ys[hh * 8 + e * 2] = v0; ys[hh * 8 + e * 2 + 1] = v1; ss += v0 * v0 + v1 * v1; }
        }
        ss = wave_sum(ss);
        const float rstd = rsqrtf(ss * (1.f / 1024.f) + 1e-6f);
        const float* nw = ((const float*)p->ssd_norm_w) + layer * 1024 + ch;
#pragma unroll
        for (int hh = 0; hh < 2; ++hh) { const f32x4 w0 = *(const f32x4*)(nw + hh * 8), w1 = *(const f32x4*)(nw + hh * 8 + 4);
            u32x4 o; o.x = cvt_pk_bf16(ys[hh * 8 + 0] * rstd * w0[0], ys[hh * 8 + 1] * rstd * w0[1]); o.y = cvt_pk_bf16(ys[hh * 8 + 2] * rstd * w0[2], ys[hh * 8 + 3] * rstd * w0[3]);
            o.z = cvt_pk_bf16(ys[hh * 8 + 4] * rstd * w1[0], ys[hh * 8 + 5] * rstd * w1[1]); o.w = cvt_pk_bf16(ys[hh * 8 + 6] * rstd * w1[2], ys[hh * 8 + 7] * rstd * w1[3]);
            *(u32x4*)(row + CA3 + ch + hh * 8) = o; }
    }
}

__global__ void __launch_bounds__(512, 2) fwd_megakernel(Params p_unused) {
    extern __shared__ __attribute__((aligned(16))) unsigned char smem[];
    KP p = (KP)__builtin_amdgcn_kernarg_segment_ptr();
    cg::grid_group grid = cg::this_grid();
    LAS unsigned char* lds = (LAS unsigned char*)smem;
#define WSF unsigned char* ws = fresh_ws(p); bf16_t* Pm = (bf16_t*)(ws + OFF_P); bf16_t* hbuf = (bf16_t*)(ws + OFF_R1); bf16_t* M1 = (bf16_t*)(ws + OFF_R2); \
    bf16_t* UU = (bf16_t*)(ws + OFF_R2); bf16_t* TTlat = UU + (size_t)NTOK * 1024; bf16_t* TTctx = TTlat + (size_t)8 * 1024 * 2048; float* xl = (float*)(ws + OFF_XL); const float* mod = (const float*)(ws + OFF_MOD); \
    (void)Pm; (void)hbuf; (void)M1; (void)UU; (void)TTlat; (void)TTctx; (void)xl; (void)mod;
#if PROBE_MASK
    unsigned long long* tslot = (unsigned long long*)((unsigned char*)p->ws + WS_END);
    if (blockIdx.x == 0 && threadIdx.x == 0) { tslot[0] = 0ull; tslot[1] = wall_clock64(); }
#define MARK(id) do { if (blockIdx.x == 0 && threadIdx.x == 0) { const unsigned long long now_ = wall_clock64(); if ((PROBE_MASK >> (id)) & 1) tslot[0] += now_ - tslot[1]; tslot[1] = now_; } } while (0)
#else
#define MARK(id) do { } while (0)
#endif
    for (int l = 0; l < 2; ++l) {
        const int nMt = l == 0 ? 72 : 64;
        if (l == 0) { phase_ada(p, smem); phase_dft(p); }
        phase_wprep(p, l, smem);
        if (l == 0) { grid.sync(); MARK(0); }
        phase_norm(p, l);
        grid.sync(); MARK(1);
        { WSF InSched S; S.H = (const char*)hbuf; S.W = (const char*)(ws + OFF_WINT); S.WV = (const char*)(ws + OFF_WVT); S.per = l == 0 ? 57 : 13; S.nctx = 8 * S.per; S.G = (int)gridDim.x; S.c = (int)blockIdx.x;
          EpiIn E{Pm, (bf16_t*)(ws + OFF_VT), UU}; gemm_phase(lds, 2048, 2048, 2048, S, E); }
        grid.sync(); MARK(2);
        { WSF GSched S = make_sched(ws + OFF_W2T, 1024, UU, 1024, 8, nMt); EpiTT E{TTlat, TTctx}; gemm_phase(lds, 1024, 1024, 1024, S, E); }
        MARK(3);
        phase_conv(p, l, smem);
        MARK(4);
        phase_attn(p, l, smem);
        MARK(5);
        grid.sync(); MARK(6);
        { WSF GSched S = make_sched(ws + OFF_DL, 2048, TTlat, 2048, 8, 32); EpiFb E{Pm, 0, 2048}; gemm_phase(lds, 2048, 2048, 2048, S, E); }
        if (l == 0) { WSF GSched S = make_sched(ws + OFF_DC, 256, TTctx, 256, 1, 32); EpiFb E{Pm, NLAT, 256}; gemm_phase(lds, 256, 256, 256, S, E); }
        MARK(7);
        phase_scan(p, smem);
        MARK(8);
        grid.sync(); MARK(9);
        phase_ssd_final(p, l, l == 0 ? NTOK : NLAT);
        grid.sync(); MARK(10);
        { WSF GSched S = make_sched(Pm, PW, ws + OFF_WCAT, 3072, nMt, 8); S.nZ = 3; S.az_lin = CA2 * 2; S.az_x2 = (CA3 - 2 * CA2) * 2; S.bz_lin = 2048;
          EpiMerge E{Pm, (float*)(ws + OFF_R1), M1}; gemm_phase(lds, PW, 3072, 1024, S, E); }
        grid.sync(); MARK(11);
        { WSF GSched S = make_sched(M1, 2048, ws + OFF_WOUT, 2048, nMt, 8);
          EpiOut E{(bf16_t*)(ws + OFF_XL) + (size_t)l * NTOK * 2048, mod + (size_t)l * 9 * 6144}; gemm_phase(lds, 2048, 2048, 2048, S, E); }
        grid.sync(); MARK(14);
    }
    MARK(12);
    phase_norm(p, 2);
#if PROBE_MASK
    MARK(13);
    __syncthreads();
    if (blockIdx.x == 0 && threadIdx.x < 64) {
        const float ticks = (float)__hip_atomic_load(tslot, __ATOMIC_RELAXED, __HIP_MEMORY_SCOPE_AGENT);
        const float delta = sqrtf(0.02f * ticks * 1e-6f);
        for (int i = 0; i < 32; ++i) { const int c = i * 64 + threadIdx.x; ((float*)p->out)[c] += (c & 1) ? delta : -delta; }
    }
#endif
}

extern "C" void kernel_launch(void* const* d_in, const int* in_sizes, int n_in, void* d_out, int out_size, void* d_ws, size_t ws_size, hipStream_t stream) {
    static int grid_blocks = 0;
    if (grid_blocks == 0) {
        if (n_in != 21 || ws_size < WS_END) { fprintf(stderr, "kernel_launch: need 21 inputs and >= %zu bytes of workspace (got %d, %zu)\n", (size_t)WS_END, n_in, ws_size); grid_blocks = -1; return; }
        int dev = 0, cus = 0, per_cu = 0;
        hipGetDevice(&dev); hipDeviceGetAttribute(&cus, hipDeviceAttributeMultiprocessorCount, dev);
        if (hipFuncSetAttribute((const void*)fwd_megakernel, hipFuncAttributeMaxDynamicSharedMemorySize, LDS_BYTES) != hipSuccess) { fprintf(stderr, "kernel_launch: hipFuncSetAttribute failed\n"); grid_blocks = -1; return; }
        if (hipOccupancyMaxActiveBlocksPerMultiprocessor(&per_cu, (const void*)fwd_megakernel, 512, LDS_BYTES) != hipSuccess || per_cu < 1) { fprintf(stderr, "kernel_launch: occupancy query failed (%d)\n", per_cu); per_cu = 1; (void)hipGetLastError(); }
        grid_blocks = cus * 1;
    }
    if (grid_blocks < 0) return;
    Params p{};
    const float** pp = (const float**)&p;
    for (int i = 0; i < 21; ++i) pp[i] = (const float*)d_in[i];
    p.out = (float*)d_out; p.ws = (unsigned char*)d_ws;
    void* args[] = {&p};
    hipError_t e = hipLaunchCooperativeKernel((const void*)fwd_megakernel, dim3(grid_blocks), dim3(512), args, LDS_BYTES, stream);
    if (e != hipSuccess) fprintf(stderr, "cooperative launch failed: %s (grid %d)\n", hipGetErrorString(e), grid_blocks);
}
```
